# Optimizing an MI355X kernel written in HIP

```python
import math
import jax, jax.numpy as jnp
from jax import lax
import numpy as np

D_MODEL = 2048
BATCH = 1
SEQ = 8192
DEPTH = 2
DEC_BATCH = 4
DEC_SEQ = 2048
PAST_LEN = 128

N_MIXERS = 2
N_LRU_LAYERS = (DEPTH + 1) // 2
N_ATTN_LAYERS = DEPTH // 2
D_RNN = D_MODEL
LRU_BLOCKS = 16
LRU_BW = D_RNN // LRU_BLOCKS
CONV_W = 4
LRU_C = 8.0
HEAD_DIM = 128
N_HEADS = D_MODEL // HEAD_DIM
N_KV = 4
GROUP = N_HEADS // N_KV
WINDOW = 128
BLOCK = 128
QKV_DIM = (N_HEADS + 2 * N_KV) * HEAD_DIM
NUM_BUCKETS = 32
MAX_DISTANCE = 128
D_FF = int(math.ceil(8 * D_MODEL / 3 / 256) * 256)
ALPHA = (2 * DEPTH) ** 0.25
BETA = (8 * DEPTH) ** -0.25
LN_EPS = 1e-5
NEG = -1e30

kernel_name = 'hybrid_rglru_swa_encoder'


def layer_norm(x, g, b):
    xf = x.astype(jnp.float32)
    mu = xf.mean(-1, keepdims=True)
    var = jnp.mean(jnp.square(xf - mu), -1, keepdims=True)
    y = (xf - mu) * lax.rsqrt(var + LN_EPS)
    return (y * g.astype(jnp.float32) + b.astype(jnp.float32)).astype(x.dtype)


def swiglu(x, w_gu, w_down):
    gu = x @ w_gu
    g, u = gu[..., :D_FF], gu[..., D_FF:]
    return (jax.nn.silu(g) * u) @ w_down


def centred_depthwise_conv(x, w, b):
    S = x.shape[1]
    left = CONV_W // 2
    xp = jnp.pad(x, ((0, 0), (left, CONV_W - 1 - left), (0, 0)))
    y = b
    for k in range(CONV_W):
        y = y + xp[:, k:k + S] * w[k]
    return y


def _lin_combine(c1, c2):
    a1, b1 = c1
    a2, b2 = c2
    return a1 * a2, a2 * b1 + b2


def linear_recurrence(a, b, reverse):
    return lax.associative_scan(_lin_combine, (a, b), reverse=reverse, axis=1)[1]


def rglru_block(x, w_in, conv_w, conv_b, gate_w, gate_b, lam, w_out):
    B, S, _ = x.shape
    proj = x @ w_in
    y_branch = jax.nn.gelu(proj[..., :D_RNN])
    xr = centred_depthwise_conv(proj[..., D_RNN:], conv_w, conv_b)
    xb = xr.reshape(B, S, LRU_BLOCKS, LRU_BW)
    g = jnp.einsum('bsni,egnio->egbsno', xb, gate_w) + gate_b[:, :, None, None]
    g = jax.nn.sigmoid(g.astype(jnp.float32)).reshape(2, 2, B, S, D_RNN)
    r, i = g[:, 0], g[:, 1]
    log_a = -LRU_C * r * jax.nn.softplus(-lam.astype(jnp.float32))[:, None, None, :]
    a = jnp.exp(log_a)
    u = jnp.sqrt(-jnp.expm1(2.0 * log_a)) * i * xr.astype(jnp.float32)[None]
    h = linear_recurrence(a[0], u[0], False) + linear_recurrence(a[1], u[1], True)
    return (y_branch * h.astype(x.dtype)) @ w_out


def t5_bucket(rel):
    nb = NUM_BUCKETS // 2
    ret = (rel > 0).astype(np.int32) * nb
    n = np.abs(rel)
    max_exact = nb // 2
    nn = np.maximum(n, 1).astype(np.float32)
    large = max_exact + (np.log(nn / max_exact) / math.log(MAX_DISTANCE / max_exact) * (nb - max_exact)).astype(np.int32)
    large = np.minimum(large, nb - 1)
    return (ret + np.where(n < max_exact, n, large)).astype(np.int32)


def band_structure(S):
    nblk = S // BLOCK
    q = np.arange(BLOCK)[:, None]
    c = np.arange(3 * BLOCK)[None, :]
    rel = c - BLOCK - q
    band = np.abs(rel) <= WINDOW
    key_abs = (np.arange(nblk)[:, None] - 1) * BLOCK + np.arange(3 * BLOCK)[None, :]
    key_ok = (key_abs >= 0) & (key_abs < S)
    mask = band[None] & key_ok[:, None, :]
    return mask, t5_bucket(rel)


def _key_windows(t, B, nblk):
    tp = jnp.pad(t, ((0, 0), (BLOCK, BLOCK), (0, 0), (0, 0)))
    tb = tp.reshape(B, nblk + 2, BLOCK, N_KV, HEAD_DIM)
    return jnp.concatenate([tb[:, :-2], tb[:, 1:-1], tb[:, 2:]], axis=2)


def windowed_gqa(x, w_qkv, sink, w_out, rel_bias):
    B, S, _ = x.shape
    nblk = S // BLOCK
    mask, bucket = band_structure(S)
    qkv = x @ w_qkv
    q = qkv[..., :N_HEADS * HEAD_DIM].reshape(B, nblk, BLOCK, N_KV, GROUP, HEAD_DIM) * (HEAD_DIM ** -0.5)
    k = qkv[..., N_HEADS * HEAD_DIM:(N_HEADS + N_KV) * HEAD_DIM].reshape(B, S, N_KV, HEAD_DIM)
    v = qkv[..., (N_HEADS + N_KV) * HEAD_DIM:].reshape(B, S, N_KV, HEAD_DIM)
    kw = _key_windows(k, B, nblk)
    vw = _key_windows(v, B, nblk)
    bias = jnp.transpose(rel_bias[bucket], (2, 0, 1)).reshape(N_KV, GROUP, BLOCK, 3 * BLOCK)
    logits = jnp.einsum('bnqkgd,bnckd->bnkgqc', q, kw).astype(jnp.float32) + bias.astype(jnp.float32)
    logits = jnp.where(mask[None, :, None, None], logits, NEG)
    s = sink.reshape(N_KV, GROUP).astype(jnp.float32)[None, None, :, :, None, None]
    m = jnp.maximum(logits.max(-1, keepdims=True), s)
    p = jnp.exp(logits - m)
    p = p / (p.sum(-1, keepdims=True) + jnp.exp(s - m))
    o = jnp.einsum('bnkgqc,bnckd->bnqkgd', p.astype(vw.dtype), vw).reshape(B, S, N_HEADS * HEAD_DIM)
    return o @ w_out


def trunk(x, lru_w_in, lru_conv_w, lru_conv_b, lru_gate_w, lru_gate_b, lru_lambda, lru_w_out,
          attn_w_qkv, attn_sink, attn_w_out, rel_bias, ffn_w_gu, ffn_w_down, ln_g, ln_b):
    for l in range(DEPTH):
        j = l // N_MIXERS
        if l % N_MIXERS == 0:
            h = rglru_block(x, lru_w_in[j], lru_conv_w[j], lru_conv_b[j], lru_gate_w[j],
                            lru_gate_b[j], lru_lambda[j], lru_w_out[j])
        else:
            h = windowed_gqa(x, attn_w_qkv[j], attn_sink[j], attn_w_out[j], rel_bias)
        x = layer_norm(ALPHA * x + h, ln_g[l, 0], ln_b[l, 0])
        x = layer_norm(ALPHA * x + swiglu(x, ffn_w_gu[l], ffn_w_down[l]), ln_g[l, 1], ln_b[l, 1])
    return x


def setup_inputs(seed: int = 0) -> dict:
    key = jax.random.key(seed)
    ks = jax.random.split(key, 20)
    nrm = jax.random.normal
    f32 = jnp.float32
    u = jax.random.uniform(ks[7], (N_LRU_LAYERS, 2, D_RNN), f32, 0.9, 0.999)
    s = u ** (1.0 / LRU_C)
    return {
        'x_prompt': nrm(ks[0], (BATCH, SEQ, D_MODEL), f32),
        'x_sample': nrm(ks[1], (DEC_BATCH, DEC_SEQ, D_MODEL), f32),
        'lru_w_in': nrm(ks[2], (N_LRU_LAYERS, D_MODEL, 2 * D_RNN), f32) * D_MODEL ** -0.5,
        'lru_conv_w': nrm(ks[3], (N_LRU_LAYERS, CONV_W, D_RNN), f32) * CONV_W ** -0.5,
        'lru_conv_b': nrm(ks[4], (N_LRU_LAYERS, D_RNN), f32) * 0.01,
        'lru_gate_w': nrm(ks[5], (N_LRU_LAYERS, 2, 2, LRU_BLOCKS, LRU_BW, LRU_BW), f32) * LRU_BW ** -0.5,
        'lru_gate_b': nrm(ks[6], (N_LRU_LAYERS, 2, 2, LRU_BLOCKS, LRU_BW), f32) * 0.01,
        'lru_lambda': jnp.log(s) - jnp.log1p(-s),
        'lru_w_out': nrm(ks[8], (N_LRU_LAYERS, D_RNN, D_MODEL), f32) * (D_RNN ** -0.5 * BETA),
        'attn_w_qkv': nrm(ks[9], (N_ATTN_LAYERS, D_MODEL, QKV_DIM), f32) * D_MODEL ** -0.5,
        'attn_sink': nrm(ks[10], (N_ATTN_LAYERS, N_HEADS), f32) * 0.5,
        'attn_w_out': nrm(ks[11], (N_ATTN_LAYERS, N_HEADS * HEAD_DIM, D_MODEL), f32) * ((N_HEADS * HEAD_DIM) ** -0.5 * BETA),
        'rel_bias': nrm(ks[12], (NUM_BUCKETS, N_HEADS), f32) * 0.2,
        'ffn_w_gu': nrm(ks[13], (DEPTH, D_MODEL, 2 * D_FF), f32) * D_MODEL ** -0.5,
        'ffn_w_down': nrm(ks[14], (DEPTH, D_FF, D_MODEL), f32) * (D_FF ** -0.5 * BETA),
        'ln_g': 1.0 + 0.02 * nrm(ks[15], (DEPTH, 2, D_MODEL), f32),
        'ln_b': 0.02 * nrm(ks[16], (DEPTH, 2, D_MODEL), f32),
    }


def reference(x_prompt, x_sample, lru_w_in, lru_conv_w, lru_conv_b, lru_gate_w, lru_gate_b, lru_lambda,
              lru_w_out, attn_w_qkv, attn_sink, attn_w_out, rel_bias, ffn_w_gu, ffn_w_down, ln_g, ln_b):
    y_prompt = trunk(x_prompt, lru_w_in, lru_conv_w, lru_conv_b, lru_gate_w, lru_gate_b, lru_lambda, lru_w_out,
                     attn_w_qkv, attn_sink, attn_w_out, rel_bias, ffn_w_gu, ffn_w_down, ln_g, ln_b)
    y_sample = trunk(x_sample, lru_w_in, lru_conv_w, lru_conv_b, lru_gate_w, lru_gate_b, lru_lambda, lru_w_out,
                     attn_w_qkv, attn_sink, attn_w_out, rel_bias, ffn_w_gu, ffn_w_down, ln_g, ln_b)
    return (y_prompt, y_sample)
```

```cpp
#include <hip/hip_runtime.h>
#include <hip/hip_cooperative_groups.h>
#include <cstdio>
namespace cg = cooperative_groups;

#define LAS __attribute__((address_space(3)))
typedef _Float16 h16;
typedef _Float16 f16x8 __attribute__((ext_vector_type(8)));
typedef _Float16 f16x4 __attribute__((ext_vector_type(4)));
typedef _Float16 f16x2 __attribute__((ext_vector_type(2)));
typedef float f32x4 __attribute__((ext_vector_type(4)));
typedef float f32x2 __attribute__((ext_vector_type(2)));
typedef unsigned u32x4 __attribute__((ext_vector_type(4)));
typedef unsigned u32x2 __attribute__((ext_vector_type(2)));

constexpr int NT = 16384, DM = 2048, DFF = 5632, NQKV = 3072;
constexpr float ALPHA = 1.41421356237309515f;
constexpr float LN_EPS = 1e-5f;
constexpr int LDS_STAGE = 131072, LDS_VEC = LDS_STAGE + 16, LDS_BYTES = LDS_VEC + 16384;

constexpr size_t SZ_WIN = (size_t)4096 * 2048 * 2, SZ_WSQ = (size_t)2048 * 2048 * 2, SZ_WGU = (size_t)11264 * 2048 * 2, SZ_WDN = (size_t)2048 * 5632 * 2, SZ_WQKV = (size_t)3072 * 2048 * 2;
constexpr size_t OFF_WIN = 0, OFF_WOUT0 = OFF_WIN + SZ_WIN, OFF_WGU0 = OFF_WOUT0 + SZ_WSQ, OFF_WDN0 = OFF_WGU0 + SZ_WGU, OFF_WQKV = OFF_WDN0 + SZ_WDN,
                 OFF_WAO = OFF_WQKV + SZ_WQKV, OFF_WGU1 = OFF_WAO + SZ_WSQ, OFF_WDN1 = OFF_WGU1 + SZ_WGU, OFF_GT = OFF_WDN1 + SZ_WDN;
constexpr size_t SZ_GT = (size_t)16 * 4 * 128 * 128 * 2, SZ_AGG = (size_t)128 * 2 * 2048 * 4;
constexpr size_t OFF_AGGA = OFF_GT + SZ_GT, OFF_AGGH = OFF_AGGA + SZ_AGG, OFF_CARRY = OFF_AGGH + SZ_AGG, OFF_BAR = OFF_CARRY + SZ_AGG, OFF_STATS = OFF_BAR + 16384, OFF_VEC = OFF_STATS + 524288, OFF_XH = OFF_VEC + 262144;
constexpr size_t ZERO_BYTES = 16384 + 524288 + 262144;
constexpr int VEC_GU0 = 0, VEC_GU1 = 2 * 11264, VEC_QKV = 4 * 11264;
constexpr size_t SZ_ACT = (size_t)NT * DM * 2;
constexpr size_t OFF_R = OFF_XH + SZ_ACT;
constexpr size_t WS_END = OFF_R + 5 * SZ_ACT;

struct Params {
    const float *x_prompt, *x_sample, *lru_w_in, *lru_conv_w, *lru_conv_b, *lru_gate_w, *lru_gate_b, *lru_lambda, *lru_w_out,
                *attn_w_qkv, *attn_sink, *attn_w_out, *rel_bias, *ffn_w_gu, *ffn_w_down, *ln_g, *ln_b;
    float* out; unsigned char* ws;
};

template <class T> __device__ __forceinline__ T* lnd(T* p) { asm volatile("" : "+s"(p)); return p; }
__device__ __forceinline__ int lnd_tid() { int t = threadIdx.x; asm volatile("" : "+v"(t)); return t; }
#define GAS __attribute__((address_space(1)))
__device__ __forceinline__ f32x4 ldg4(const float* p) { return *(const GAS f32x4*)(p); }
__device__ __forceinline__ f32x2 ldg2(const float* p) { return *(const GAS f32x2*)(p); }
__device__ __forceinline__ void stg4(float* p, f32x4 v) { *(GAS f32x4*)p = v; }
__device__ __forceinline__ void stg4h(h16* p, u32x4 v) { *(GAS u32x4*)p = v; }
__device__ __forceinline__ void lds_barrier() { asm volatile("s_waitcnt lgkmcnt(0)\n\ts_barrier" ::: "memory"); }
__device__ __forceinline__ unsigned pk2(float a, float b) { f16x2 v; v.x = (h16)a; v.y = (h16)b; return __builtin_bit_cast(unsigned, v); }
__device__ __forceinline__ float fast_rcp(float x) { return __builtin_amdgcn_rcpf(x); }
__device__ __forceinline__ float sigmoidf_(float x) { return fast_rcp(1.0f + __expf(-x)); }
__device__ __forceinline__ float gelu_tanh(float x) { const float y = 1.5957691216057308f * (x + 0.044715f * x * x * x); return x * fast_rcp(1.0f + __expf(-y)); }
__device__ __forceinline__ float silu_(float x) { return x * fast_rcp(1.0f + __expf(-x)); }
__device__ __forceinline__ void seq_bounds(int t, int& s0, int& s1) { if (t < 8192) { s0 = 0; s1 = 8192; } else { s0 = 8192 + ((t - 8192) >> 11 << 11); s1 = s0 + 2048; } }

namespace pg8 {
constexpr int BM = 256, BK = 64, HALF = 128, HTB = HALF * BK * 2, NXCD = 8, WGM = 8;
__device__ __forceinline__ int lds_byte(int r, int c) { const int st = (r >> 4) * 2 + (c >> 5), rr = r & 15, cc = c & 31, ob = rr * 64 + cc * 2; return st * 1024 + (ob ^ (((ob >> 9) & 1) << 5)); }
__device__ __forceinline__ void stage_rc(int b, int& R, int& C) { const int st = b / 1024, sb = b % 1024, swz = sb ^ (((sb >> 9) & 1) << 5); R = (st >> 1) * 16 + swz / 64; C = (st & 1) * 32 + (swz % 64) / 2; }
__device__ __forceinline__ int perm32(int rho) { const int n = rho >> 4, i = rho & 15; return 8 * (i >> 2) + 4 * n + (i & 3); }
struct Unit { int pm, pn; };
struct Gemm { const h16* A; const h16* Bt; int M, N, K; };
struct StaticOrder {
    int nM, nN, nwg, G, c;
    __device__ void init(int M, int N, int G_, int c_) { nM = M / BM; nN = N / BM; nwg = nM * nN; G = G_; c = c_; }
    __device__ bool next(int i, Unit& u) const {
        const long L = (long)i * G + c; if (L >= nwg) return false;
        int wgid = (int)L; { const int q = nwg / NXCD, r = nwg % NXCD, xcd = wgid % NXCD, off = wgid / NXCD; wgid = (xcd < r ? xcd * (q + 1) : r * (q + 1) + (xcd - r) * q) + off; }
        const int nig = WGM * nN, gid = wgid / nig, fm = gid * WGM, gsz = (nM - fm) < WGM ? (nM - fm) : WGM;
        u.pm = fm + ((wgid % nig) % gsz); u.pn = (wgid % nig) / gsz; return true;
    }
};


__device__ __forceinline__ void row_mu_rstd(const float* stats, int row, float& mu, float& rs) {
    const f32x2 st = ldg2(stats + 2 * (size_t)row); mu = st.x * (1.0f / DM); rs = rsqrtf(fmaxf(st.y * (1.0f / DM) - mu * mu, 0.f) + LN_EPS); }
__device__ __forceinline__ void rows_mu_rstd(const float* stats, int row0, float (&mu)[2][4], float (&rs)[2][4]) {
    f32x2 st[8];
#pragma unroll
    for (int i = 0; i < 8; ++i) st[i] = ldg2(stats + 2 * (size_t)(row0 + (i >> 2) * 128 + (i & 3) * 16));
    asm volatile("" : "+v"(st[0].x), "+v"(st[0].y), "+v"(st[1].x), "+v"(st[1].y), "+v"(st[2].x), "+v"(st[2].y), "+v"(st[3].x), "+v"(st[3].y),
                      "+v"(st[4].x), "+v"(st[4].y), "+v"(st[5].x), "+v"(st[5].y), "+v"(st[6].x), "+v"(st[6].y), "+v"(st[7].x), "+v"(st[7].y));
#pragma unroll
    for (int i = 0; i < 8; ++i) { const float m_ = st[i].x * (1.0f / DM); mu[i >> 2][i & 3] = m_; rs[i >> 2][i & 3] = rsqrtf(fmaxf(st[i].y * (1.0f / DM) - m_ * m_, 0.f) + LN_EPS); }
}
__device__ __forceinline__ void lnfold_prefetch(LAS float* vl, const float* stats, const float* gW, const float* bW, const Unit& u, int wr, int wc, int lane) {
    LAS float* slot = vl + (wr * 4 + wc) * 512;
    const int rowb = u.pm * BM + wr * 64 + (lane >> 5) * HALF + (lane & 31) * 2;
    const int col = u.pn * BM + wc * 32 + (lane < 32 ? lane : 96 + lane);
    __builtin_amdgcn_global_load_lds((const unsigned*)(stats + 2 * (size_t)rowb), (LAS unsigned*)slot, 16, 0, 0);
    __builtin_amdgcn_global_load_lds((const unsigned*)(gW + col), (LAS unsigned*)(slot + 256), 4, 0, 0);
    __builtin_amdgcn_global_load_lds((const unsigned*)(bW + col), (LAS unsigned*)(slot + 320), 4, 0, 0);
}
__device__ __forceinline__ void lnfold_rows(const LAS float* slot, int fr, float (&mu)[2][4], float (&rs)[2][4]) {
#pragma unroll
    for (int i = 0; i < 8; ++i) { const f32x2 st = *(const LAS f32x2*)(slot + 2 * ((i >> 2) * 64 + (i & 3) * 16 + fr));
        const float m_ = st.x * (1.0f / DM); mu[i >> 2][i & 3] = m_; rs[i >> 2][i & 3] = rsqrtf(fmaxf(st.y * (1.0f / DM) - m_ * m_, 0.f) + LN_EPS); }
}
struct EpiRes {
    static constexpr bool PERM = true, PREF = false;
    __device__ __forceinline__ void prefetch(const Unit&, int, int, int) const {}
    const float* res0; const float* res1; float* out;
    const float* pstats; const float* pg; const float* pb;
    const float* tg; h16* zh; float* tstats;
    LAS float* vl;
    h16* zf;
    __device__ __forceinline__ const float* resrow(int row, int colb) const { return (row < 8192 ? res0 + (size_t)row * DM : res1 + (size_t)(row - 8192) * DM) + colb; }
    __device__ __forceinline__ void operator()(f32x4 (&acc)[2][2][4][2], const Unit& u, int wr, int wc, int fr, int fq) const {
        const int row0 = u.pm * BM + wr * 64 + fr, colb = u.pn * BM + wc * 32 + 8 * fq;
        const bool hasln = pstats != nullptr, haszh = zh != nullptr;
        LAS float* slot = vl + (wr * 4 + wc) * 256;
        f32x4 rn[2][2]; float ssm[8], ssq[8]; f32x2 stn = {0.f, 0.f};
        { const int lane = fr + 16 * fq, cL = u.pn * BM + wc * 32 + (lane < 32 ? lane : 96 + lane);
          float vg = 0.f, vb = 0.f, vt = 0.f;
          if (hasln) { vg = *(const GAS float*)(pg + cL); vb = *(const GAS float*)(pb + cL); }
          if (haszh) vt = *(const GAS float*)(tg + cL);
          const float* rp = resrow(row0, colb);
#pragma unroll
          for (int bj = 0; bj < 2; ++bj) { rn[bj][0] = ldg4(rp + bj * HALF); rn[bj][1] = ldg4(rp + bj * HALF + 4); }
          if (hasln) stn = ldg2(pstats + 2 * (size_t)row0);
          asm volatile("" : "+v"(vg), "+v"(vb), "+v"(vt), "+v"(rn[0][0]), "+v"(rn[0][1]), "+v"(rn[1][0]), "+v"(rn[1][1]), "+v"(stn));
          slot[lane] = vg; slot[64 + lane] = vb; slot[128 + lane] = vt;
        }
#pragma unroll
        for (int ai = 0; ai < 2; ++ai)
#pragma unroll
            for (int m = 0; m < 4; ++m) {
                const int row = row0 + ai * HALF + m * 16;
                f32x4 r[2][2]; const f32x2 st = stn;
#pragma unroll
                for (int bj = 0; bj < 2; ++bj) { r[bj][0] = rn[bj][0]; r[bj][1] = rn[bj][1]; }
                if (ai * 4 + m < 7) { const int rown = row0 + ((ai * 4 + m + 1) >> 2) * HALF + ((ai * 4 + m + 1) & 3) * 16; const float* rp = resrow(rown, colb);
#pragma unroll
                    for (int bj = 0; bj < 2; ++bj) { rn[bj][0] = ldg4(rp + bj * HALF); rn[bj][1] = ldg4(rp + bj * HALF + 4); }
                    if (hasln) stn = ldg2(pstats + 2 * (size_t)rown);
                }
                float* op = out + (size_t)row * DM + colb; h16* zp = zh + (size_t)row * DM + colb;
                float mu = 0.f, rs = 1.f; if (hasln) { mu = st.x * (1.0f / DM); rs = rsqrtf(fmaxf(st.y * (1.0f / DM) - mu * mu, 0.f) + LN_EPS); }
                float sm = 0.f, sq = 0.f;
#pragma unroll
                for (int bj = 0; bj < 2; ++bj) {
                    f32x4 r0 = r[bj][0], r1 = r[bj][1];
                    if (hasln) { const f32x4 g0 = *(const LAS f32x4*)(slot + bj * 32 + 8 * fq), g1 = *(const LAS f32x4*)(slot + bj * 32 + 8 * fq + 4),
                                             b0 = *(const LAS f32x4*)(slot + 64 + bj * 32 + 8 * fq), b1 = *(const LAS f32x4*)(slot + 64 + bj * 32 + 8 * fq + 4);
                        r0 = (r0 - mu) * rs * g0 + b0; r1 = (r1 - mu) * rs * g1 + b1; }
                    const f32x4 z0 = r0 * ALPHA + acc[ai][bj][m][0], z1 = r1 * ALPHA + acc[ai][bj][m][1];
                    if (zf == nullptr) { stg4(op + bj * HALF, z0); stg4(op + bj * HALF + 4, z1); }
                    else { u32x4 w; w.x = pk2(z0[0], z0[1]); w.y = pk2(z0[2], z0[3]); w.z = pk2(z1[0], z1[1]); w.w = pk2(z1[2], z1[3]); stg4h(zf + (size_t)row * DM + colb + bj * HALF, w); }
                    sm += ((z0[0] + z0[1]) + (z0[2] + z0[3])) + ((z1[0] + z1[1]) + (z1[2] + z1[3]));
                    sq += ((z0[0] * z0[0] + z0[1] * z0[1]) + (z0[2] * z0[2] + z0[3] * z0[3])) + ((z1[0] * z1[0] + z1[1] * z1[1]) + (z1[2] * z1[2] + z1[3] * z1[3]));
                    if (haszh) {
                        const f32x4 t0 = *(const LAS f32x4*)(slot + 128 + bj * 32 + 8 * fq), t1 = *(const LAS f32x4*)(slot + 128 + bj * 32 + 8 * fq + 4);
                        const f32x4 y0 = z0 * t0, y1 = z1 * t1;
                        u32x4 w; w.x = pk2(y0[0], y0[1]); w.y = pk2(y0[2], y0[3]); w.z = pk2(y1[0], y1[1]); w.w = pk2(y1[2], y1[3]);
                        stg4h(zp + bj * HALF, w); }
                }
                sm += __shfl_xor(sm, 16); sm += __shfl_xor(sm, 32); sq += __shfl_xor(sq, 16); sq += __shfl_xor(sq, 32);
                ssm[ai * 4 + m] = sm; ssq[ai * 4 + m] = sq;
                asm volatile("" ::: "memory");
            }
        if (haszh) {
#pragma unroll
            for (int ai = 0; ai < 2; ++ai)
#pragma unroll
                for (int mp = 0; mp < 2; ++mp) {
                    const float lo = (fq & 1) ? ssq[ai * 4 + 2 * mp] : ssm[ai * 4 + 2 * mp], hi = (fq & 1) ? ssq[ai * 4 + 2 * mp + 1] : ssm[ai * 4 + 2 * mp + 1];
                    const float v = (fq & 2) ? hi : lo; const size_t row = (size_t)(row0 + ai * HALF + (2 * mp + (fq >> 1)) * 16);
                    __hip_atomic_fetch_add((GAS float*)(tstats + 2 * row + (fq & 1)), v, __ATOMIC_RELAXED, __HIP_MEMORY_SCOPE_AGENT);
                }
        }
    }
};
struct EpiProj {
    static constexpr bool PERM = true, PREF = false;
    __device__ __forceinline__ void prefetch(const Unit&, int, int, int) const {}
    h16* ybr; h16* xpre;
    __device__ __forceinline__ void operator()(f32x4 (&acc)[2][2][4][2], const Unit& u, int wr, int wc, int fr, int fq) const {
        const bool isy = u.pn < 8; h16* dst = isy ? ybr : xpre; const int colb = (isy ? u.pn : u.pn - 8) * BM + wc * 32 + 8 * fq;
        const int row0 = u.pm * BM + wr * 64 + fr;
#pragma unroll
        for (int ai = 0; ai < 2; ++ai)
#pragma unroll
            for (int m = 0; m < 4; ++m) { h16* rowp = dst + (size_t)(row0 + ai * HALF + m * 16) * DM + colb;
#pragma unroll
                for (int bj = 0; bj < 2; ++bj) { f32x4 v0 = acc[ai][bj][m][0], v1 = acc[ai][bj][m][1];
                    if (isy) {
#pragma unroll
                        for (int j = 0; j < 4; ++j) { v0[j] = gelu_tanh(v0[j]); v1[j] = gelu_tanh(v1[j]); } }
                    u32x4 w; w.x = pk2(v0[0], v0[1]); w.y = pk2(v0[2], v0[3]); w.z = pk2(v1[0], v1[1]); w.w = pk2(v1[2], v1[3]);
                    stg4h(rowp + bj * HALF, w);  } }
    }
};
struct EpiGU {
    static constexpr bool PERM = true, PREF = true;
    h16* act; const float* stats; const float* gW; const float* bW; LAS float* vl;
    __device__ __forceinline__ void prefetch(const Unit& u, int wr, int wc, int lane) const { lnfold_prefetch(vl, stats, gW, bW, u, wr, wc, lane); }
    __device__ __forceinline__ void operator()(f32x4 (&acc)[2][2][4][2], const Unit& u, int wr, int wc, int fr, int fq) const {
        const int row0 = u.pm * BM + wr * 64 + fr, colb = u.pn * HALF + wc * 32 + 8 * fq, vb = u.pn * BM + wc * 32 + 8 * fq;
        float mu[2][4], rs[2][4]; f32x4 wg[2], wu[2], cg_[2], cu[2];
        const LAS float* slot = vl + (wr * 4 + wc) * 512;
#pragma unroll
        for (int n = 0; n < 2; ++n) { wg[n] = *(const LAS f32x4*)(slot + 256 + 8 * fq + 4 * n); wu[n] = *(const LAS f32x4*)(slot + 288 + 8 * fq + 4 * n);
                                      cg_[n] = *(const LAS f32x4*)(slot + 320 + 8 * fq + 4 * n); cu[n] = *(const LAS f32x4*)(slot + 352 + 8 * fq + 4 * n); }
        lnfold_rows(slot, fr, mu, rs); (void)vb;
#pragma unroll
        for (int ai = 0; ai < 2; ++ai)
#pragma unroll
            for (int m = 0; m < 4; ++m) { const int row = row0 + ai * HALF + m * 16; h16* rowp = act + (size_t)row * DFF + colb;
                float a[8];
#pragma unroll
                for (int n = 0; n < 2; ++n) {
                    const f32x4 gv = (acc[ai][0][m][n] - mu[ai][m] * wg[n]) * rs[ai][m] + cg_[n], uv = (acc[ai][1][m][n] - mu[ai][m] * wu[n]) * rs[ai][m] + cu[n];
#pragma unroll
                    for (int j = 0; j < 4; ++j) a[4 * n + j] = silu_(gv[j]) * uv[j];
                }
                u32x4 w; w.x = pk2(a[0], a[1]); w.y = pk2(a[2], a[3]); w.z = pk2(a[4], a[5]); w.w = pk2(a[6], a[7]);
                stg4h(rowp, w); }
    }
};
struct EpiQKV {
    static constexpr bool PERM = true, PREF = true;
    h16* q; h16* k; h16* vT; const float* stats; const float* gW; const float* bW; LAS float* vl;
    __device__ __forceinline__ void prefetch(const Unit& u, int wr, int wc, int lane) const { lnfold_prefetch(vl, stats, gW, bW, u, wr, wc, lane); }
    __device__ __forceinline__ void operator()(f32x4 (&acc)[2][2][4][2], const Unit& u, int wr, int wc, int fr, int fq) const {
        const int row0 = u.pm * BM + wr * 64 + fr, vb = u.pn * BM + wc * 32 + 8 * fq;
        {
            float mu[2][4], rs[2][4]; f32x4 w[2][2], c[2][2];
            const LAS float* slot = vl + (wr * 4 + wc) * 512;
            lnfold_rows(slot, fr, mu, rs); (void)vb;
#pragma unroll
            for (int bj = 0; bj < 2; ++bj)
#pragma unroll
                for (int n = 0; n < 2; ++n) { w[bj][n] = *(const LAS f32x4*)(slot + 256 + bj * 32 + 8 * fq + 4 * n); c[bj][n] = *(const LAS f32x4*)(slot + 320 + bj * 32 + 8 * fq + 4 * n); }
            if (u.pn < 8) {
                const float qs = 0.08838834764831845f * 1.4426950408889634f;
#pragma unroll
                for (int i = 0; i < 8; ++i) rs[i >> 2][i & 3] *= qs;
#pragma unroll
                for (int bj = 0; bj < 2; ++bj)
#pragma unroll
                    for (int n = 0; n < 2; ++n) c[bj][n] *= qs;
            }
#pragma unroll
            for (int ai = 0; ai < 2; ++ai)
#pragma unroll
                for (int m = 0; m < 4; ++m)
#pragma unroll
                    for (int bj = 0; bj < 2; ++bj)
#pragma unroll
                        for (int n = 0; n < 2; ++n) acc[ai][bj][m][n] = (acc[ai][bj][m][n] - mu[ai][m] * w[bj][n]) * rs[ai][m] + c[bj][n];
        }
        if (u.pn < 10) {
            const bool isq = u.pn < 8; h16* dst = isq ? q : k; const int ld = isq ? 2048 : 512; const int colb = (isq ? u.pn : u.pn - 8) * BM + wc * 32 + 8 * fq;
#pragma unroll
            for (int ai = 0; ai < 2; ++ai)
#pragma unroll
                for (int m = 0; m < 4; ++m) { h16* rowp = dst + (size_t)(row0 + ai * HALF + m * 16) * ld + colb;
#pragma unroll
                    for (int bj = 0; bj < 2; ++bj) { const f32x4 v0 = acc[ai][bj][m][0], v1 = acc[ai][bj][m][1];
                        u32x4 w; w.x = pk2(v0[0], v0[1]); w.y = pk2(v0[2], v0[3]); w.z = pk2(v1[0], v1[1]); w.w = pk2(v1[2], v1[3]);
                        stg4h(rowp + bj * HALF, w); } }
        } else {
            const int colb = (u.pn - 10) * BM + wc * 32 + 8 * fq;
#pragma unroll
            for (int ai = 0; ai < 2; ++ai)
#pragma unroll
                for (int m = 0; m < 4; ++m) { const int row = row0 + ai * HALF + m * 16;
#pragma unroll
                    for (int bj = 0; bj < 2; ++bj)
#pragma unroll
                        for (int n = 0; n < 2; ++n)
#pragma unroll
                            for (int j = 0; j < 4; ++j) *(GAS h16*)(vT + (size_t)(colb + bj * HALF + 4 * n + j) * NT + row) = (h16)acc[ai][bj][m][n][j];
                    asm volatile("" ::: "memory"); }
        }
    }
};

template <class Epi>
__device__ __forceinline__ void gemm_phase(LAS unsigned char* lds, const Gemm g0, const StaticOrder& S, const Epi& E) {
    Gemm g = g0; g.A = lnd(g.A); g.Bt = lnd(g.Bt);
    const int tid = lnd_tid(), wid = __builtin_amdgcn_readfirstlane(tid >> 6), lane = tid & 63, wr = wid >> 2, wc = wid & 3, fr = lane & 15, fq = lane >> 4;
    const int K = g.K, nt = K / BK;
    unsigned voffA[2], voffB[2];
#pragma unroll
    for (int i = 0; i < 2; ++i) { int R, C; stage_rc(tid * 16 + i * 8192, R, C); const int Rb = Epi::PERM ? ((R & ~31) + perm32(R & 31)) : R;
        voffA[i] = (unsigned)(R * K + C) * 2u; voffB[i] = (unsigned)(Rb * K + C) * 2u; }
    const size_t kstep = (size_t)(BK * 2);
    const size_t hstep = (size_t)HALF * K * 2;
    const size_t tstep = 2 * hstep;
    const unsigned ldsw = (unsigned)wid * 1024u;
    const int aoff = lds_byte(wr * 64 + fr, fq * 8), boff = lds_byte(wc * 32 + fr, fq * 8);
#define PG8_SA(b, h) (((b) * 2 + (h)) * HTB)
#define PG8_SB(b, h) ((4 + (b) * 2 + (h)) * HTB)
#define PG8_STAGE(bufoff, gbase, voff) do { _Pragma("unroll") for (int _i = 0; _i < 2; ++_i) \
        __builtin_amdgcn_global_load_lds((const unsigned*)((const char*)(gbase) + (voff)[_i]), (LAS unsigned*)(lds + (bufoff) + ldsw + _i * 8192), 16, 0, 0); } while (0)
#define PG8_LDA(dst, b, h) do { _Pragma("unroll") for (int m = 0; m < 4; ++m) _Pragma("unroll") for (int k = 0; k < 2; ++k) dst[m][k] = *(const LAS f16x8*)(lds + PG8_SA(b, h) + aoff + m * 2048 + k * 1024); } while (0)
#define PG8_LDB(dst, b, h) do { _Pragma("unroll") for (int n = 0; n < 2; ++n) _Pragma("unroll") for (int k = 0; k < 2; ++k) dst[n][k] = *(const LAS f16x8*)(lds + PG8_SB(b, h) + boff + n * 2048 + k * 1024); } while (0)
#define PG8_MMA(ai, bj, At, Bt) do { __builtin_amdgcn_s_setprio(1); _Pragma("unroll") for (int m = 0; m < 4; ++m) _Pragma("unroll") for (int n = 0; n < 2; ++n) _Pragma("unroll") for (int k = 0; k < 2; ++k) \
        acc[ai][bj][m][n] = __builtin_amdgcn_mfma_f32_16x16x32_f16(Bt[n][k], At[m][k], acc[ai][bj][m][n], 0, 0, 0); __builtin_amdgcn_s_setprio(0); } while (0)
#define PG8_WAIT_V(n) asm volatile("s_waitcnt vmcnt(" #n ")" ::: "memory")
#define PG8_WAIT_L(n) asm volatile("s_waitcnt lgkmcnt(" #n ")" ::: "memory")
#define PG8_BAR __builtin_amdgcn_s_barrier()
#define PG8_SCHED __builtin_amdgcn_sched_barrier(0)
    Unit cur, nxt; int ui = 0;
    if (!S.next(0, cur)) return;
    f32x4 acc[2][2][4][2];
#pragma unroll
    for (int a = 0; a < 2; ++a)
#pragma unroll
        for (int b = 0; b < 2; ++b)
#pragma unroll
            for (int m = 0; m < 4; ++m)
#pragma unroll
                for (int n = 0; n < 2; ++n) acc[a][b][m][n] = (f32x4){0.f, 0.f, 0.f, 0.f};
    f16x8 At[4][2], B0[2][2], B1[2][2];
    const char* cA = (const char*)g.A + (size_t)cur.pm * tstep; const char* cB = (const char*)g.Bt + (size_t)cur.pn * tstep;
    PG8_STAGE(PG8_SB(0, 0), cB, voffB); PG8_STAGE(PG8_SA(0, 0), cA, voffA); PG8_STAGE(PG8_SB(0, 1), cB + hstep, voffB); PG8_STAGE(PG8_SA(0, 1), cA + hstep, voffA);
    if (wr == 1) PG8_BAR;
    PG8_WAIT_V(4); PG8_BAR;
    PG8_STAGE(PG8_SB(1, 0), cB + kstep, voffB); PG8_STAGE(PG8_SA(1, 0), cA + kstep, voffA); PG8_STAGE(PG8_SB(1, 1), cB + hstep + kstep, voffB);
    PG8_WAIT_V(6); PG8_BAR;
    for (;;) {
        const bool has_next = S.next(ui + 1, nxt);
        const char* nA = has_next ? (const char*)g.A + (size_t)nxt.pm * tstep : cA; const char* nB = has_next ? (const char*)g.Bt + (size_t)nxt.pn * tstep : cB;
        for (int t = 0; t < nt; t += 2) {
            const bool last = (t == nt - 2);
            if (Epi::PREF && last) E.prefetch(cur, wr, wc, lane);
            const char* a1 = cA + (size_t)(t + 1) * kstep;
            const char* a2 = last ? nA : cA + (size_t)(t + 2) * kstep; const char* b2 = last ? nB : cB + (size_t)(t + 2) * kstep;
            const char* a3 = a2 + kstep; const char* b3 = b2 + kstep;
            PG8_LDB(B0, 0, 0); PG8_SCHED; PG8_LDA(At, 0, 0); PG8_STAGE(PG8_SA(1, 1), a1 + hstep, voffA);
            PG8_WAIT_L(8); PG8_BAR; PG8_WAIT_L(0); PG8_MMA(0, 0, At, B0); PG8_BAR; PG8_SCHED;
            PG8_LDB(B1, 0, 1); PG8_STAGE(PG8_SB(0, 0), b2, voffB);
            PG8_BAR; PG8_WAIT_L(0); PG8_MMA(0, 1, At, B1); PG8_BAR;
            PG8_LDA(At, 0, 1); PG8_STAGE(PG8_SA(0, 0), a2, voffA);
            PG8_BAR; PG8_WAIT_L(0); PG8_MMA(1, 0, At, B0); PG8_BAR; PG8_SCHED;
            PG8_STAGE(PG8_SB(0, 1), b2 + hstep, voffB);
            PG8_WAIT_V(6); PG8_BAR; PG8_MMA(1, 1, At, B1); PG8_BAR;
            PG8_LDB(B0, 1, 0); PG8_SCHED; PG8_LDA(At, 1, 0); PG8_STAGE(PG8_SA(0, 1), a2 + hstep, voffA);
            PG8_WAIT_L(8); PG8_BAR; PG8_WAIT_L(0); PG8_MMA(0, 0, At, B0); PG8_BAR; PG8_SCHED;
            PG8_LDB(B1, 1, 1); PG8_STAGE(PG8_SB(1, 0), b3, voffB);
            PG8_BAR; PG8_WAIT_L(0); PG8_MMA(0, 1, At, B1); PG8_BAR;
            PG8_LDA(At, 1, 1); PG8_STAGE(PG8_SA(1, 0), a3, voffA);
            PG8_BAR; PG8_WAIT_L(0); PG8_MMA(1, 0, At, B0); PG8_BAR; PG8_SCHED;
            PG8_STAGE(PG8_SB(1, 1), b3 + hstep, voffB);
            PG8_WAIT_V(6); PG8_BAR; PG8_MMA(1, 1, At, B1); PG8_BAR;
        }
        if (Epi::PREF) asm volatile("s_waitcnt vmcnt(16)" ::: "memory");
        E(acc, cur, wr, wc, fr, fq);
        if (!has_next) break;
#pragma unroll
        for (int a = 0; a < 2; ++a)
#pragma unroll
            for (int b = 0; b < 2; ++b)
#pragma unroll
                for (int m = 0; m < 4; ++m)
#pragma unroll
                    for (int n = 0; n < 2; ++n) acc[a][b][m][n] = (f32x4){0.f, 0.f, 0.f, 0.f};
        cur = nxt; cA = nA; cB = nB; ++ui;
    }
    PG8_WAIT_V(0);
    if (wr == 0) PG8_BAR;
    PG8_BAR;
#undef PG8_SA
#undef PG8_SB
#undef PG8_STAGE
#undef PG8_LDA
#undef PG8_LDB
#undef PG8_MMA
#undef PG8_WAIT_V
#undef PG8_WAIT_L
#undef PG8_BAR
#undef PG8_SCHED
}
}

template <bool LNV>
__device__ __forceinline__ void conv_tile(const float* src, int src_ld, h16* dst, int dst_ld, unsigned* L, const float* gam, const float* bet, float* gW, float* bW) {
    const int tid = lnd_tid(), nq = tid & 15, kp = tid >> 4;
    const f32x4 a = ldg4(src + (size_t)(2 * kp) * src_ld + 4 * nq);
    const f32x4 b = ldg4(src + (size_t)(2 * kp + 1) * src_ld + 4 * nq);
    L[(4 * nq + 0) * 33 + kp] = pk2(a.x, b.x); L[(4 * nq + 1) * 33 + kp] = pk2(a.y, b.y); L[(4 * nq + 2) * 33 + kp] = pk2(a.z, b.z); L[(4 * nq + 3) * 33 + kp] = pk2(a.w, b.w);
    lds_barrier();
    const int n = tid >> 3, c = tid & 7;
    u32x4 v; v.x = L[n * 33 + 4 * c]; v.y = L[n * 33 + 4 * c + 1]; v.z = L[n * 33 + 4 * c + 2]; v.w = L[n * 33 + 4 * c + 3];
    *(GAS u32x4*)(dst + (size_t)n * dst_ld + 8 * c) = v;
    if (LNV) {
        const f16x8 hv = __builtin_bit_cast(f16x8, v);
        const f32x4 g0 = *(const f32x4*)(gam + 8 * c), g1 = *(const f32x4*)(gam + 8 * c + 4), b0 = *(const f32x4*)(bet + 8 * c), b1 = *(const f32x4*)(bet + 8 * c + 4);
        float sg = 0.f, sb = 0.f;
#pragma unroll
        for (int j = 0; j < 4; ++j) { sg += g0[j] * (float)hv[j] + g1[j] * (float)hv[4 + j]; sb += b0[j] * (float)hv[j] + b1[j] * (float)hv[4 + j]; }
        sg += __shfl_xor(sg, 1); sg += __shfl_xor(sg, 2); sg += __shfl_xor(sg, 4); sb += __shfl_xor(sb, 1); sb += __shfl_xor(sb, 2); sb += __shfl_xor(sb, 4);
        if (c == 0) { __hip_atomic_fetch_add((GAS float*)(gW + n), sg, __ATOMIC_RELAXED, __HIP_MEMORY_SCOPE_AGENT); __hip_atomic_fetch_add((GAS float*)(bW + n), sb, __ATOMIC_RELAXED, __HIP_MEMORY_SCOPE_AGENT); }
    }
    lds_barrier();
}
template <int MODE, bool LNV>
__device__ __forceinline__ void conv_matrix(const float* src, int K, int N, h16* dst, unsigned* L, const float* gam, const float* bet, float* gW, float* bW, int& rot) {
    const int nsn = N / 256, ntk = K / 64, total = nsn * ntk, G = gridDim.x;
    const int tid = lnd_tid(), nq = tid & 15, kp = tid >> 4, n = tid >> 3, c = tid & 7;
    f32x4 ra[4], rb[4], rc[4], rd[4];
#define CM_ISSUE(RA, RB, st_) do { const int tk_ = (st_) / nsn, sn_ = (st_) % nsn; _Pragma("unroll") for (int j = 0; j < 4; ++j) { const int n0_ = sn_ * 256 + 64 * j; \
        const int sc_ = MODE ? ((j >> 1) * 5632 + sn_ * 128 + (j & 1) * 64) : n0_; const float* p_ = src + (size_t)(tk_ * 64 + 2 * kp) * N + sc_ + 4 * nq; \
        RA[j] = ldg4(p_); RB[j] = ldg4(p_ + N); } } while (0)
#define CM_STEP(RA, RB, st_) do { const int tk = (st_) / nsn, sn = (st_) % nsn; \
        _Pragma("unroll") for (int j = 0; j < 4; ++j) { unsigned* Lj = L + j * 2112; \
            Lj[(4 * nq + 0) * 33 + kp] = pk2(RA[j].x, RB[j].x); Lj[(4 * nq + 1) * 33 + kp] = pk2(RA[j].y, RB[j].y); Lj[(4 * nq + 2) * 33 + kp] = pk2(RA[j].z, RB[j].z); Lj[(4 * nq + 3) * 33 + kp] = pk2(RA[j].w, RB[j].w); } \
        lds_barrier(); \
        if ((st_) + 2 * G < total) CM_ISSUE(RA, RB, (st_) + 2 * G); \
        f32x4 g0, g1, b0, b1; \
        if (LNV) { g0 = ldg4(gam + tk * 64 + 8 * c); g1 = ldg4(gam + tk * 64 + 8 * c + 4); b0 = ldg4(bet + tk * 64 + 8 * c); b1 = ldg4(bet + tk * 64 + 8 * c + 4); } \
        _Pragma("unroll") for (int j = 0; j < 4; ++j) { const unsigned* Lj = L + j * 2112; const int n0 = sn * 256 + 64 * j; \
            u32x4 v; v.x = Lj[n * 33 + 4 * c]; v.y = Lj[n * 33 + 4 * c + 1]; v.z = Lj[n * 33 + 4 * c + 2]; v.w = Lj[n * 33 + 4 * c + 3]; \
            *(GAS u32x4*)(dst + (size_t)(n0 + n) * K + tk * 64 + 8 * c) = v; \
            if (LNV) { const f16x8 hv = __builtin_bit_cast(f16x8, v); float sg = 0.f, sb = 0.f; \
                _Pragma("unroll") for (int q = 0; q < 4; ++q) { sg += g0[q] * (float)hv[q] + g1[q] * (float)hv[4 + q]; sb += b0[q] * (float)hv[q] + b1[q] * (float)hv[4 + q]; } \
                sg += __shfl_xor(sg, 1); sg += __shfl_xor(sg, 2); sg += __shfl_xor(sg, 4); sb += __shfl_xor(sb, 1); sb += __shfl_xor(sb, 2); sb += __shfl_xor(sb, 4); \
                if (c == 0) { __hip_atomic_fetch_add((GAS float*)(gW + n0 + n), sg, __ATOMIC_RELAXED, __HIP_MEMORY_SCOPE_AGENT); __hip_atomic_fetch_add((GAS float*)(bW + n0 + n), sb, __ATOMIC_RELAXED, __HIP_MEMORY_SCOPE_AGENT); } } } \
        lds_barrier(); } while (0)
    int st = ((int)blockIdx.x - rot + G) % G; rot = (rot + total) % G;
    if (st < total) CM_ISSUE(ra, rb, st);
    if (st + G < total) CM_ISSUE(rc, rd, st + G);
    for (; st < total; st += 2 * G) {
        CM_STEP(ra, rb, st);
        if (st + G < total) CM_STEP(rc, rd, st + G);
    }
#undef CM_STEP
#undef CM_ISSUE
}
__device__ void phase0(const Params& p, unsigned* L) {
    unsigned char* ws = lnd(p.ws);
    float* vec = (float*)(ws + OFF_VEC); int rot = 0;
    conv_matrix<0, false>(p.lru_w_in, 2048, 4096, (h16*)(ws + OFF_WIN), L, nullptr, nullptr, nullptr, nullptr, rot);
    conv_matrix<0, false>(p.lru_w_out, 2048, 2048, (h16*)(ws + OFF_WOUT0), L, nullptr, nullptr, nullptr, nullptr, rot);
    conv_matrix<0, true>(p.attn_w_qkv, 2048, 3072, (h16*)(ws + OFF_WQKV), L, p.ln_g + 1 * DM, p.ln_b + 1 * DM, vec + VEC_QKV, vec + VEC_QKV + 3072, rot);
    conv_matrix<0, false>(p.attn_w_out, 2048, 2048, (h16*)(ws + OFF_WAO), L, nullptr, nullptr, nullptr, nullptr, rot);
    conv_matrix<1, true>(p.ffn_w_gu, 2048, 11264, (h16*)(ws + OFF_WGU0), L, p.ln_g + 0 * DM, p.ln_b + 0 * DM, vec + VEC_GU0, vec + VEC_GU0 + 11264, rot);
    conv_matrix<1, true>(p.ffn_w_gu + (size_t)2048 * 11264, 2048, 11264, (h16*)(ws + OFF_WGU1), L, p.ln_g + 2 * DM, p.ln_b + 2 * DM, vec + VEC_GU1, vec + VEC_GU1 + 11264, rot);
    conv_matrix<0, false>(p.ffn_w_down, 5632, 2048, (h16*)(ws + OFF_WDN0), L, nullptr, nullptr, nullptr, nullptr, rot);
    conv_matrix<0, false>(p.ffn_w_down + (size_t)5632 * 2048, 5632, 2048, (h16*)(ws + OFF_WDN1), L, nullptr, nullptr, nullptr, nullptr, rot);
    for (int tile = blockIdx.x; tile < 256; tile += gridDim.x) {
        const int mat = tile >> 2, sub = tile & 3, ti = sub >> 1, to = sub & 1;
        const int eg = mat >> 4, n = mat & 15;
        conv_tile<false>(p.lru_gate_w + (size_t)mat * 16384 + (size_t)(ti * 64) * 128 + to * 64, 128,
                  (h16*)(ws + OFF_GT) + (size_t)(n * 4 + eg) * 16384 + (size_t)(to * 64) * 128 + ti * 64, 128, L, nullptr, nullptr, nullptr, nullptr);
    }
    h16* xh = (h16*)(ws + OFF_XH);
    const size_t nchunk = (size_t)NT * DM / 8, half = (size_t)8192 * DM / 8;
    const size_t stride = (size_t)gridDim.x * 512;
    for (size_t i = (size_t)blockIdx.x * 512 + lnd_tid(); i < nchunk; i += 4 * stride) {
        f32x4 a[4], b[4];
#pragma unroll
        for (int q = 0; q < 4; ++q) { const size_t k = i + q * stride; const float* sp = (k < half) ? p.x_prompt + k * 8 : p.x_sample + (k - half) * 8; a[q] = ldg4(sp); b[q] = ldg4(sp + 4); }
#pragma unroll
        for (int q = 0; q < 4; ++q) { const size_t k = i + q * stride;
            u32x4 w; w.x = pk2(a[q].x, a[q].y); w.y = pk2(a[q].z, a[q].w); w.z = pk2(b[q].x, b[q].y); w.w = pk2(b[q].z, b[q].w);
            *(GAS u32x4*)(xh + k * 8) = w; }
    }
}

constexpr int XR_LD = 136;
__device__ __forceinline__ float one_minus_exp2la(float la, float a) {
    const float y = 2.0f * la;
    const float poly = -y * (1.0f + y * (0.5f + y * (1.0f / 6.0f + y * (1.0f / 24.0f + y * (1.0f / 120.0f + y * (1.0f / 720.0f))))));
    return (y > -0.25f) ? poly : (1.0f - a * a);
}
__device__ __forceinline__ f32x4 exp2v(f32x4 x) { f32x4 r; r[0] = __builtin_amdgcn_exp2f(x[0]); r[1] = __builtin_amdgcn_exp2f(x[1]); r[2] = __builtin_amdgcn_exp2f(x[2]); r[3] = __builtin_amdgcn_exp2f(x[3]); return r; }
__device__ __forceinline__ f32x4 rcpv(f32x4 x) { f32x4 r; r[0] = __builtin_amdgcn_rcpf(x[0]); r[1] = __builtin_amdgcn_rcpf(x[1]); r[2] = __builtin_amdgcn_rcpf(x[2]); r[3] = __builtin_amdgcn_rcpf(x[3]); return r; }
__device__ __forceinline__ void gate_au(f32x4 ar, f32x4 ai, float gbr, float gbi, float nsp, f32x4 xv, f32x4& a, f32x4& u) {
    const float L2E = 1.4426950408889634f;
    const f32x4 rg = rcpv(exp2v(ar * (-L2E) + (-L2E * gbr)) + 1.0f), ig = rcpv(exp2v(ai * (-L2E) + (-L2E * gbi)) + 1.0f);
    const f32x4 la = rg * nsp; a = exp2v(la * L2E);
    const f32x4 y = la + la;
    const f32x4 poly = -y * (y * (y * (y * (y * (y * (1.0f / 720.0f) + (1.0f / 120.0f)) + (1.0f / 24.0f)) + (1.0f / 6.0f)) + 0.5f) + 1.0f);
    f32x4 polyp = poly, dir = 1.0f - a * a;
    asm volatile("" : "+v"(polyp), "+v"(dir));
    f32x4 om;
#pragma unroll
    for (int j = 0; j < 4; ++j) om[j] = (y[j] > -0.25f) ? polyp[j] : dir[j];
    f32x4 sq; sq[0] = __builtin_amdgcn_sqrtf(om[0]); sq[1] = __builtin_amdgcn_sqrtf(om[1]); sq[2] = __builtin_amdgcn_sqrtf(om[2]); sq[3] = __builtin_amdgcn_sqrtf(om[3]);
    u = sq * ig * xv;
}
__device__ void lru_local_phase(const Params& p, unsigned char* ldsb) {
    unsigned char* ws = lnd(p.ws);
    const GAS h16* xpre = (const GAS h16*)(ws + OFF_R + SZ_ACT);
    GAS h16* HL = (GAS h16*)(ws + OFF_R + 2 * SZ_ACT); GAS h16* PF = (GAS h16*)(ws + OFF_R + 3 * SZ_ACT); GAS h16* PB = (GAS h16*)(ws + OFF_R + 4 * SZ_ACT);
    GAS float* aggA = (GAS float*)(ws + OFF_AGGA); GAS float* aggH = (GAS float*)(ws + OFF_AGGH);
    const GAS h16* Gt = (const GAS h16*)(ws + OFF_GT);
    h16* xr = (h16*)ldsb;
    const int tid = lnd_tid(), w = tid >> 6, lane = tid & 63, fr = lane & 15, fq = lane >> 4;
    const int nblk = blockIdx.x >> 4, tile0 = (blockIdx.x & 15) * 8;
    const int cl = 16 * w + fr, c = 128 * nblk + cl;
    float gb[4], nsp[2];
#pragma unroll
    for (int eg = 0; eg < 4; ++eg) gb[eg] = ((const GAS float*)p.lru_gate_b)[(eg * 16 + nblk) * 128 + cl];
#pragma unroll
    for (int e = 0; e < 2; ++e) { const float x = -((const GAS float*)p.lru_lambda)[e * 2048 + c]; nsp[e] = -8.0f * (fmaxf(x, 0.f) + log1pf(expf(-fabsf(x)))); }
    const int cg8 = (tid & 15) * 8, tg = tid >> 4;

    f16x8 pre[7];
#define LRU_PRELOAD(tile_) do { const int t0_ = (tile_) * 128; int s0_, s1_; seq_bounds(t0_, s0_, s1_); _Pragma("unroll") for (int i = 0; i < 7; ++i) { \
        const int tr = t0_ + 4 * tg - 2 + i; pre[i] = (f16x8){0, 0, 0, 0, 0, 0, 0, 0}; \
        if (tr >= s0_ && tr < s1_) pre[i] = *(const GAS f16x8*)(xpre + (size_t)tr * DM + 128 * nblk + cg8); } } while (0)
    LRU_PRELOAD(tile0);
    for (int it = 0; it < 8; ++it) {
        const int tile = tile0 + it, t0 = tile * 128;
        {
            float cw[4][8], cb[8];
            { const float* cbp = p.lru_conv_b + 128 * nblk + cg8; const f32x4 b0 = ldg4(cbp), b1 = ldg4(cbp + 4);
#pragma unroll
              for (int j = 0; j < 4; ++j) { cb[j] = b0[j]; cb[4 + j] = b1[j]; }
#pragma unroll
              for (int k = 0; k < 4; ++k) { const float* wp = p.lru_conv_w + k * 2048 + 128 * nblk + cg8; const f32x4 w0 = ldg4(wp), w1 = ldg4(wp + 4);
#pragma unroll
                  for (int j = 0; j < 4; ++j) { cw[k][j] = w0[j]; cw[k][4 + j] = w1[j]; } } }
            float o[4][8];
#pragma unroll
            for (int j = 0; j < 4; ++j)
#pragma unroll
                for (int q = 0; q < 8; ++q) o[j][q] = cb[q];
#pragma unroll
            for (int i = 0; i < 7; ++i) {
                const f16x8 v = pre[i];
#pragma unroll
                for (int j = 0; j < 4; ++j) { const int k = i - j; if (k >= 0 && k < 4) {
#pragma unroll
                        for (int q = 0; q < 8; ++q) o[j][q] += cw[k][q] * (float)v[q]; } }
            }
#pragma unroll
            for (int j = 0; j < 4; ++j) { u32x4 wv; wv.x = pk2(o[j][0], o[j][1]); wv.y = pk2(o[j][2], o[j][3]); wv.z = pk2(o[j][4], o[j][5]); wv.w = pk2(o[j][6], o[j][7]);
                *(u32x4*)(xr + (4 * tg + j) * XR_LD + cg8) = wv; }
        }
        lds_barrier();
        float* hfl = (float*)(ldsb + 128 * XR_LD * 2);
        const size_t tg0 = (size_t)(t0 >> 2);
        {
            float Prun = 1.f, hrun = 0.f;
            f16x8 Bf[2][4];
#pragma unroll
            for (int eg = 0; eg < 2; ++eg)
#pragma unroll
                for (int ks = 0; ks < 4; ++ks) Bf[eg][ks] = *(const GAS f16x8*)(Gt + ((size_t)(nblk * 4 + eg) * 128 + cl) * 128 + 32 * ks + 8 * fq);
#pragma unroll
            for (int m = 0; m < 8; ++m) {
                f32x4 ar = {0.f, 0.f, 0.f, 0.f}, ai = {0.f, 0.f, 0.f, 0.f};
#pragma unroll
                for (int ks = 0; ks < 4; ++ks) { const f16x8 Af = *(const f16x8*)(xr + (16 * m + fr) * XR_LD + 32 * ks + 8 * fq);
                    ar = __builtin_amdgcn_mfma_f32_16x16x32_f16(Af, Bf[0][ks], ar, 0, 0, 0); ai = __builtin_amdgcn_mfma_f32_16x16x32_f16(Af, Bf[1][ks], ai, 0, 0, 0); }
                f32x4 xv, a, u;
#pragma unroll
                for (int r = 0; r < 4; ++r) xv[r] = (float)xr[(16 * m + 4 * fq + r) * XR_LD + cl];
                gate_au(ar, ai, gb[0], gb[1], nsp[0], xv, a, u);
                float A = (a[0] * a[1]) * (a[2] * a[3]); float H = u[0]; H = a[1] * H + u[1]; H = a[2] * H + u[2]; H = a[3] * H + u[3];
                { const float A1 = __shfl(A, (lane - 16) & 63), H1 = __shfl(H, (lane - 16) & 63); if (fq >= 1) { H = A * H1 + H; A = A1 * A; } }
                { const float A2 = __shfl(A, (lane - 32) & 63), H2 = __shfl(H, (lane - 32) & 63); if (fq >= 2) { H = A * H2 + H; A = A2 * A; } }
                float Ae = __shfl(A, (lane - 16) & 63), He = __shfl(H, (lane - 16) & 63); if (fq == 0) { Ae = 1.f; He = 0.f; }
                const float At = __shfl(A, 48 + fr), Ht = __shfl(H, 48 + fr);
                float Pst = Prun * Ae, hst = Ae * hrun + He; f32x4 hv, pv;
#pragma unroll
                for (int r = 0; r < 4; ++r) { hst = a[r] * hst + u[r]; Pst *= a[r]; hv[r] = hst; pv[r] = Pst; }
                *(f32x4*)(hfl + ((m * 4 + fq) * 128 + cl) * 4) = hv;
                { u32x2 w; w.x = pk2(pv[0], pv[1]); w.y = pk2(pv[2], pv[3]); *(GAS u32x2*)(PF + ((tg0 + 4 * m + fq) * DM + c) * 4) = w; }
                hrun = At * hrun + Ht; Prun = Prun * At;
            }
            if (fq == 0) { aggA[(size_t)(tile * 2 + 0) * 2048 + c] = Prun; aggH[(size_t)(tile * 2 + 0) * 2048 + c] = hrun; }
        }
        if (it < 7) LRU_PRELOAD(tile + 1);
        {
            float Prun = 1.f, hrun = 0.f;
            f16x8 Bf[2][4];
#pragma unroll
            for (int eg = 0; eg < 2; ++eg)
#pragma unroll
                for (int ks = 0; ks < 4; ++ks) Bf[eg][ks] = *(const GAS f16x8*)(Gt + ((size_t)(nblk * 4 + 2 + eg) * 128 + cl) * 128 + 32 * ks + 8 * fq);
#pragma unroll
            for (int mm = 0; mm < 8; ++mm) { const int m = 7 - mm;
                f32x4 ar = {0.f, 0.f, 0.f, 0.f}, ai = {0.f, 0.f, 0.f, 0.f};
#pragma unroll
                for (int ks = 0; ks < 4; ++ks) { const f16x8 Af = *(const f16x8*)(xr + (16 * m + fr) * XR_LD + 32 * ks + 8 * fq);
                    ar = __builtin_amdgcn_mfma_f32_16x16x32_f16(Af, Bf[0][ks], ar, 0, 0, 0); ai = __builtin_amdgcn_mfma_f32_16x16x32_f16(Af, Bf[1][ks], ai, 0, 0, 0); }
                f32x4 xv, a, u;
#pragma unroll
                for (int r = 0; r < 4; ++r) xv[r] = (float)xr[(16 * m + 4 * fq + r) * XR_LD + cl];
                gate_au(ar, ai, gb[2], gb[3], nsp[1], xv, a, u);
                float A = (a[0] * a[1]) * (a[2] * a[3]); float H = u[3]; H = a[2] * H + u[2]; H = a[1] * H + u[1]; H = a[0] * H + u[0];
                { const float A1 = __shfl(A, (lane + 16) & 63), H1 = __shfl(H, (lane + 16) & 63); if (fq <= 2) { H = A * H1 + H; A = A1 * A; } }
                { const float A2 = __shfl(A, (lane + 32) & 63), H2 = __shfl(H, (lane + 32) & 63); if (fq <= 1) { H = A * H2 + H; A = A2 * A; } }
                float Ae = __shfl(A, (lane + 16) & 63), He = __shfl(H, (lane + 16) & 63); if (fq == 3) { Ae = 1.f; He = 0.f; }
                const float At = __shfl(A, fr), Ht = __shfl(H, fr);
                float Pst = Prun * Ae, hst = Ae * hrun + He; f32x4 hv, pv;
#pragma unroll
                for (int rr = 0; rr < 4; ++rr) { const int r = 3 - rr; hst = a[r] * hst + u[r]; Pst *= a[r]; hv[r] = hst; pv[r] = Pst; }
                const f32x4 hfv = *(const f32x4*)(hfl + ((m * 4 + fq) * 128 + cl) * 4); const f32x4 hs = hfv + hv;
                const size_t o = ((tg0 + 4 * m + fq) * DM + c) * 4;
                { u32x2 w; w.x = pk2(pv[0], pv[1]); w.y = pk2(pv[2], pv[3]); *(GAS u32x2*)(PB + o) = w; }
                { u32x2 w; w.x = pk2(hs[0], hs[1]); w.y = pk2(hs[2], hs[3]); *(GAS u32x2*)(HL + o) = w; }
                hrun = At * hrun + Ht; Prun = Prun * At;
            }
            if (fq == 0) { aggA[(size_t)(tile * 2 + 1) * 2048 + c] = Prun; aggH[(size_t)(tile * 2 + 1) * 2048 + c] = hrun; }
        }
        lds_barrier();
    }
}
__device__ void lru_carry_phase(const Params& p) {
    unsigned char* ws = lnd(p.ws);
    const GAS float* aggA = (const GAS float*)(ws + OFF_AGGA); const GAS float* aggH = (const GAS float*)(ws + OFF_AGGH); GAS float* carry = (GAS float*)(ws + OFF_CARRY);
    const int gt = blockIdx.x * 512 + lnd_tid();
    if (gt >= 5 * 2 * 2048) return;
    const int seq = gt / 4096, rem = gt % 4096, dir = rem / 2048, c = rem % 2048;
    const int tile0 = seq == 0 ? 0 : 64 + 16 * (seq - 1), ntile = seq == 0 ? 64 : 16;
    float cy = 0.f;
    for (int b = 0; b < ntile; b += 8) {
        float Hh[8], Aa[8]; size_t idx[8];
#pragma unroll
        for (int u = 0; u < 8; ++u) { const int j = dir == 0 ? tile0 + b + u : tile0 + ntile - 1 - b - u; idx[u] = (size_t)(j * 2 + dir) * 2048 + c; Hh[u] = aggH[idx[u]]; Aa[u] = aggA[idx[u]]; }
#pragma unroll
        for (int u = 0; u < 8; ++u) { carry[idx[u]] = cy; cy = Hh[u] + Aa[u] * cy; }
    }
}
__device__ void lru_fixup_phase(const Params& p) {
    unsigned char* ws = lnd(p.ws);
    const GAS h16* YB = (const GAS h16*)(ws + OFF_R); const GAS h16* HL = (const GAS h16*)(ws + OFF_R + 2 * SZ_ACT); const GAS h16* PF = (const GAS h16*)(ws + OFF_R + 3 * SZ_ACT); const GAS h16* PB = (const GAS h16*)(ws + OFF_R + 4 * SZ_ACT);
    const GAS float* carry = (const GAS float*)(ws + OFF_CARRY); GAS h16* out = (GAS h16*)(ws + OFF_XH);
    for (int i = blockIdx.x * 512 + lnd_tid(); i < (NT / 4) * 256; i += gridDim.x * 512) {
        const int tg = i >> 8, c8 = (i & 255) * 8, tile = tg >> 5; const size_t o4 = ((size_t)tg * DM + c8) * 4;
        f16x8 hl[4], pf[4], pb[4], y[4];
#pragma unroll
        for (int q = 0; q < 4; ++q) { hl[q] = *(const GAS f16x8*)(HL + o4 + 8 * q); pf[q] = *(const GAS f16x8*)(PF + o4 + 8 * q); pb[q] = *(const GAS f16x8*)(PB + o4 + 8 * q); y[q] = *(const GAS f16x8*)(YB + (size_t)(4 * tg + q) * DM + c8); }
        const GAS float* cf = carry + (size_t)(tile * 2) * 2048 + c8; const GAS float* cbk = cf + 2048;
        const f32x4 cf0 = *(const GAS f32x4*)cf, cf1 = *(const GAS f32x4*)(cf + 4), cb0 = *(const GAS f32x4*)cbk, cb1 = *(const GAS f32x4*)(cbk + 4);
#pragma unroll
        for (int r = 0; r < 4; ++r) {
            float v[8];
#pragma unroll
            for (int j = 0; j < 8; ++j) { const float cfj = j < 4 ? cf0[j & 3] : cf1[j & 3], cbj = j < 4 ? cb0[j & 3] : cb1[j & 3]; const int e = (j & 1) * 4 + r;
                v[j] = (float)y[r][j] * ((float)hl[j >> 1][e] + (float)pf[j >> 1][e] * cfj + (float)pb[j >> 1][e] * cbj); }
            u32x4 wv; wv.x = pk2(v[0], v[1]); wv.y = pk2(v[2], v[3]); wv.z = pk2(v[4], v[5]); wv.w = pk2(v[6], v[7]);
            *(GAS u32x4*)(out + (size_t)(4 * tg + r) * DM + c8) = wv;
        }
    }
}

__device__ void ln_final_phase(const h16* z0, const float* g0, const float* b0, float* out0) {
    const GAS h16* z = (const GAS h16*)lnd(z0); const float* g = lnd(g0); const float* b = lnd(b0); float* out = lnd(out0);
    const int tidl = lnd_tid(), lane = tidl & 63, gw = blockIdx.x * 8 + (tidl >> 6), nw = gridDim.x * 8;
    for (int row0 = gw; row0 < NT; row0 += 2 * nw) {
        f16x8 hv[2][4];
#pragma unroll
        for (int r = 0; r < 2; ++r)
#pragma unroll
            for (int i = 0; i < 4; ++i) hv[r][i] = *(const GAS f16x8*)(z + (size_t)(row0 + r * nw) * DM + 8 * (lane + 64 * i));
#pragma unroll
        for (int r = 0; r < 2; ++r) {
            const int row = row0 + r * nw; float s = 0.f;
#pragma unroll
            for (int i = 0; i < 4; ++i)
#pragma unroll
                for (int j = 0; j < 8; ++j) s += (float)hv[r][i][j];
#pragma unroll
            for (int o = 32; o >= 1; o >>= 1) s += __shfl_xor(s, o);
            const float mean = s * (1.0f / DM); float q = 0.f;
#pragma unroll
            for (int i = 0; i < 4; ++i)
#pragma unroll
                for (int j = 0; j < 8; ++j) { const float d = (float)hv[r][i][j] - mean; q += d * d; }
#pragma unroll
            for (int o = 32; o >= 1; o >>= 1) q += __shfl_xor(q, o);
            const float rstd = rsqrtf(q * (1.0f / DM) + LN_EPS);
#pragma unroll
            for (int i = 0; i < 4; ++i) { const int col = 8 * (lane + 64 * i);
                const f32x4 g0v = ldg4(g + col), g1v = ldg4(g + col + 4), b0v = ldg4(b + col), b1v = ldg4(b + col + 4);
                f32x4 y0, y1;
#pragma unroll
                for (int j = 0; j < 4; ++j) { y0[j] = ((float)hv[r][i][j] - mean) * rstd * g0v[j] + b0v[j]; y1[j] = ((float)hv[r][i][4 + j] - mean) * rstd * g1v[j] + b1v[j]; }
                stg4(out + (size_t)row * DM + col, y0); stg4(out + (size_t)row * DM + col + 4, y1); }
        }
    }
}

constexpr int KS_LD = 136, VS_LD = 72, BT_LD = 384;
__device__ void attn_phase(const Params& p, unsigned char* ldsb) {
    unsigned char* ws = lnd(p.ws);
    const GAS h16* Q = (const GAS h16*)(ws + OFF_R); const GAS h16* Kk = (const GAS h16*)(ws + OFF_R + SZ_ACT); const GAS h16* VT = (const GAS h16*)(ws + OFF_R + SZ_ACT + (size_t)NT * 512 * 2);
    GAS h16* O = (GAS h16*)(ws + OFF_XH);
    constexpr int KVB = 64 * KS_LD * 2 + 128 * VS_LD * 2;
    float* Bt = (float*)(ldsb + 2 * KVB);
    const int tid = lnd_tid(), w = tid >> 6, lane = tid & 63, fr = lane & 15, fq = lane >> 4;
    const int kvh = blockIdx.x & 3, g = w >> 1, h = kvh * 4 + g, qhalf = w & 1;
    for (int i = tid; i < 4 * BT_LD; i += 512) { const int gg = i / BT_LD, rel = i % BT_LD - 192, n = rel < 0 ? -rel : rel;
        int bk; if (n < 8) bk = n; else { int lg = (31 - __clz(n * n)) - 6; bk = 8 + lg; if (bk > 15) bk = 15; }
        if (rel > 0) bk += 16;
        Bt[i] = (n <= 128) ? ((const GAS float*)p.rel_bias)[bk * 16 + kvh * 4 + gg] * 1.4426950408889634f : -1.0e30f; }
    lds_barrier();
    const float sk = ((const GAS float*)p.attn_sink)[h] * 1.4426950408889634f;
    const int kkey = tid >> 4, kdc = (tid & 15) * 8;
    const int vd = tid >> 3, vkc = (tid & 7) * 8;
    for (int it = 0; it < 4; ++it) {
        const int item = blockIdx.x + 256 * it, qb = item >> 2, t0 = qb * 64; int s0, s1; seq_bounds(t0, s0, s1);
        int qtok[2]; f16x8 Qf[2][4];
#pragma unroll
        for (int qt = 0; qt < 2; ++qt) { qtok[qt] = t0 + 32 * qhalf + 16 * qt + fr;
#pragma unroll
            for (int ks = 0; ks < 4; ++ks) Qf[qt][ks] = *(const GAS f16x8*)(Q + (size_t)qtok[qt] * DM + h * 128 + 32 * ks + 8 * fq); }
        float mrun[2] = {sk, sk}, lrun[2]; lrun[0] = lrun[1] = (fq == 0) ? 1.f : 0.f;
        f32x4 Oa[8][2];
#pragma unroll
        for (int dt = 0; dt < 8; ++dt) { Oa[dt][0] = (f32x4){0.f, 0.f, 0.f, 0.f}; Oa[dt][1] = (f32x4){0.f, 0.f, 0.f, 0.f}; }
        int kt_lo = 0, kt_hi = 4;
        while (t0 - 128 + 64 * kt_lo < s0) ++kt_lo;
        while (t0 - 128 + 64 * kt_hi + 64 > s1) --kt_hi;
        u32x4 pk0, pk1, pv0, pv1;
        { const int kb = t0 - 128 + 64 * kt_lo;
          pk0 = *(const GAS u32x4*)(Kk + (size_t)(kb + kkey) * 512 + kvh * 128 + kdc); pk1 = *(const GAS u32x4*)(Kk + (size_t)(kb + kkey + 32) * 512 + kvh * 128 + kdc);
          pv0 = *(const GAS u32x4*)(VT + (size_t)(kvh * 128 + vd) * NT + kb + vkc); pv1 = *(const GAS u32x4*)(VT + (size_t)(kvh * 128 + vd + 64) * NT + kb + vkc); }
        lds_barrier();
        { h16* Kw = (h16*)ldsb; h16* Vw = Kw + 64 * KS_LD;
          *(u32x4*)(Kw + kkey * KS_LD + kdc) = pk0; *(u32x4*)(Kw + (kkey + 32) * KS_LD + kdc) = pk1;
          *(u32x4*)(Vw + vd * VS_LD + vkc) = pv0; *(u32x4*)(Vw + (vd + 64) * VS_LD + vkc) = pv1; }
        for (int kt = kt_lo; kt <= kt_hi; ++kt) {
            const int kb = t0 - 128 + 64 * kt, cur = (kt - kt_lo) & 1;
            const h16* Ks = (const h16*)(ldsb + cur * KVB); const h16* Vs = Ks + 64 * KS_LD;
            if (kt < kt_hi) { const int kn = kb + 64;
                pk0 = *(const GAS u32x4*)(Kk + (size_t)(kn + kkey) * 512 + kvh * 128 + kdc); pk1 = *(const GAS u32x4*)(Kk + (size_t)(kn + kkey + 32) * 512 + kvh * 128 + kdc);
                pv0 = *(const GAS u32x4*)(VT + (size_t)(kvh * 128 + vd) * NT + kn + vkc); pv1 = *(const GAS u32x4*)(VT + (size_t)(kvh * 128 + vd + 64) * NT + kn + vkc); }
            lds_barrier();
            f32x4 S[4][2];
#pragma unroll
            for (int kp = 0; kp < 4; ++kp)
#pragma unroll
                for (int qt = 0; qt < 2; ++qt) { const float* bp = Bt + g * BT_LD + (kb + 4 * fq - qtok[qt] + 192) + 16 * kp;
                    S[kp][qt] = (f32x4){bp[0], bp[1], bp[2], bp[3]}; }
#pragma unroll
            for (int ks = 0; ks < 4; ++ks)
#pragma unroll
                for (int kp = 0; kp < 4; ++kp) { const f16x8 Kf = *(const f16x8*)(Ks + (16 * kp + fr) * KS_LD + 32 * ks + 8 * fq);
                    S[kp][0] = __builtin_amdgcn_mfma_f32_16x16x32_f16(Kf, Qf[0][ks], S[kp][0], 0, 0, 0);
                    S[kp][1] = __builtin_amdgcn_mfma_f32_16x16x32_f16(Kf, Qf[1][ks], S[kp][1], 0, 0, 0); }
            f16x8 Pf[2][2];
#pragma unroll
            for (int qt = 0; qt < 2; ++qt) {
                float tmax = -3.0e38f;
#pragma unroll
                for (int kp = 0; kp < 4; ++kp)
#pragma unroll
                    for (int r = 0; r < 4; ++r) tmax = fmaxf(tmax, S[kp][qt][r]);
                tmax = fmaxf(tmax, __shfl_xor(tmax, 16)); tmax = fmaxf(tmax, __shfl_xor(tmax, 32));
                if (__builtin_amdgcn_ballot_w64(tmax > mrun[qt] + 8.0f) != 0ull) {
                    const float mnew = fmaxf(mrun[qt], tmax), alpha = __builtin_amdgcn_exp2f(mrun[qt] - mnew); mrun[qt] = mnew; lrun[qt] *= alpha;
#pragma unroll
                    for (int dt = 0; dt < 8; ++dt) Oa[dt][qt] *= alpha;
                }
                const float mref = mrun[qt];
                float ls = 0.f;
#pragma unroll
                for (int kp = 0; kp < 4; ++kp)
#pragma unroll
                    for (int r = 0; r < 4; ++r) { const float pe = __builtin_amdgcn_exp2f(S[kp][qt][r] - mref); S[kp][qt][r] = pe; ls += pe; }
                lrun[qt] += ls;
#pragma unroll
                for (int i = 0; i < 2; ++i) { f16x8 pf;
#pragma unroll
                    for (int j = 0; j < 4; ++j) { pf[j] = (h16)S[2 * i][qt][j]; pf[4 + j] = (h16)S[2 * i + 1][qt][j]; }
                    Pf[i][qt] = pf; }
            }
#pragma unroll
            for (int dt = 0; dt < 8; ++dt)
#pragma unroll
                for (int i = 0; i < 2; ++i) {
                    const f16x4 va = *(const f16x4*)(Vs + (16 * dt + fr) * VS_LD + 32 * i + 4 * fq), vb = *(const f16x4*)(Vs + (16 * dt + fr) * VS_LD + 32 * i + 16 + 4 * fq);
                    const f16x8 Vf = __builtin_shufflevector(va, vb, 0, 1, 2, 3, 4, 5, 6, 7);
                    Oa[dt][0] = __builtin_amdgcn_mfma_f32_16x16x32_f16(Vf, Pf[i][0], Oa[dt][0], 0, 0, 0);
                    Oa[dt][1] = __builtin_amdgcn_mfma_f32_16x16x32_f16(Vf, Pf[i][1], Oa[dt][1], 0, 0, 0); }
            if (kt < kt_hi) { h16* Kw = (h16*)(ldsb + (cur ^ 1) * KVB); h16* Vw = Kw + 64 * KS_LD;
                *(u32x4*)(Kw + kkey * KS_LD + kdc) = pk0; *(u32x4*)(Kw + (kkey + 32) * KS_LD + kdc) = pk1;
                *(u32x4*)(Vw + vd * VS_LD + vkc) = pv0; *(u32x4*)(Vw + (vd + 64) * VS_LD + vkc) = pv1; }
        }
#pragma unroll
        for (int qt = 0; qt < 2; ++qt) { float l = lrun[qt]; l += __shfl_xor(l, 16); l += __shfl_xor(l, 32); const float inv = 1.0f / l;
#pragma unroll
            for (int dt = 0; dt < 8; ++dt) { const f32x4 o = Oa[dt][qt] * inv; u32x2 wv; wv.x = pk2(o[0], o[1]); wv.y = pk2(o[2], o[3]);
                *(GAS u32x2*)(O + (size_t)qtok[qt] * DM + h * 128 + 16 * dt + 4 * fq) = wv; } }
    }
}

#define XB_TMO      128
#define XB_XCNT(j)  (256  + 64 * (j))
#define XB_XSUB(j)  (1280 + 64 * (j))
#define XB_XGEN(j)  (2304 + 64 * (j))
#define XB_TOP      3328
#define XB_TOPGEN   3392
#define XCD_BAR_WORDS 3456
#define XB_SPIN_CAP (1u << 20)
__device__ __forceinline__ unsigned xb_ld(unsigned* p)              { return __hip_atomic_load(p, __ATOMIC_RELAXED, __HIP_MEMORY_SCOPE_AGENT); }
__device__ __forceinline__ unsigned xb_add(unsigned* p, unsigned v) { return __hip_atomic_fetch_add(p, v, __ATOMIC_RELAXED, __HIP_MEMORY_SCOPE_AGENT); }
__device__ __forceinline__ unsigned xb_xcc_id() { return (unsigned)__builtin_amdgcn_s_getreg((3 << 11) | 20) & 0xFu; }
#define XB_SPIN(cond, bar) do { unsigned _sp = 0; while (cond) { __builtin_amdgcn_s_sleep(1); \
    if ((++_sp & 255u) == 0u) { if (xb_ld(&(bar)[XB_TMO])) break; if (_sp > XB_SPIN_CAP) { atomicAdd(&(bar)[XB_TMO], 1u); break; } } } } while (0)
struct XcdBarrier { unsigned* bar; unsigned x; volatile LAS unsigned* st; };
__device__ __forceinline__ XcdBarrier xcd_barrier_post(unsigned* bar, volatile LAS unsigned* st) {
    XcdBarrier b; b.bar = bar; b.x = xb_xcc_id(); b.st = st;
    if (threadIdx.x == 0) (void)xb_add(&bar[XB_XCNT(b.x)], 1u);
    return b;
}
__device__ __forceinline__ void xcd_barrier_complete(unsigned* bar, unsigned x, unsigned& nloc, unsigned& nx) {
    const unsigned G = gridDim.x * gridDim.y * gridDim.z;
    unsigned sum, cnt, mine, sp = 0u;
    for (;;) {
        sum = 0u; cnt = 0u; mine = 0u;
#pragma unroll
        for (unsigned j = 0; j < 16; ++j) { const unsigned c = xb_ld(&bar[XB_XCNT(j)]); sum += c; cnt += (c > 0u) ? 1u : 0u; mine = (j == x) ? c : mine; }
        if (sum == G) break;
        __builtin_amdgcn_s_sleep(1);
        if ((++sp & 255u) == 0u) { if (xb_ld(&bar[XB_TMO])) break; if (sp > XB_SPIN_CAP) { atomicAdd(&bar[XB_TMO], 1u); break; } }
    }
    nloc = mine > 0u ? mine : 1u; nx = cnt > 0u ? cnt : 1u;
}
__device__ __forceinline__ void xcd_barrier_census(const XcdBarrier& b) {
    if (threadIdx.x == 0) { unsigned nloc, nx; xcd_barrier_complete(b.bar, b.x, nloc, nx); b.st[0] = nloc; b.st[1] = nx; }
    __syncthreads();
}
__device__ __forceinline__ void xcd_barrier(const XcdBarrier& b) {
    asm volatile("s_waitcnt vmcnt(0)" ::: "memory");
    __syncthreads();
    if (threadIdx.x == 0) {
        unsigned* bar = b.bar;
        __builtin_amdgcn_s_waitcnt(0);
        const unsigned nloc = b.st[0], nx = b.st[1];
        const unsigned old = xb_add(&bar[XB_XSUB(b.x)], 1u);
        const unsigned gen = old / nloc;
        if (old + 1u == (gen + 1u) * nloc) {
            __builtin_amdgcn_fence(__ATOMIC_RELEASE, "agent");
            asm volatile("s_waitcnt vmcnt(0)" ::: "memory");
            const unsigned og = xb_add(&bar[XB_TOP], 1u);
            const unsigned tg = og / nx;
            if (og + 1u == (tg + 1u) * nx) xb_add(&bar[XB_TOPGEN], 1u);
            else XB_SPIN(xb_ld(&bar[XB_TOPGEN]) == tg, bar);
            __builtin_amdgcn_fence(__ATOMIC_ACQUIRE, "agent");
            xb_add(&bar[XB_XGEN(b.x)], 1u);
            asm volatile("s_waitcnt vmcnt(0)" ::: "memory");
        } else {
            XB_SPIN(xb_ld(&bar[XB_XGEN(b.x)]) == gen, bar);
            __builtin_amdgcn_fence(__ATOMIC_ACQUIRE, "agent");
            asm volatile("s_waitcnt vmcnt(0)" ::: "memory");
        }
    }
    __syncthreads();
}

__global__ void __launch_bounds__(512, 2) mega_fwd(Params p) {
    extern __shared__ __attribute__((aligned(16))) unsigned char lds[];
    cg::grid_group grid = cg::this_grid();
    unsigned char* ws = lnd(p.ws);
    LAS unsigned char* ldsl = (LAS unsigned char*)lds;
    const int G = gridDim.x, bid = blockIdx.x;
    volatile LAS unsigned* xst = (volatile LAS unsigned*)(ldsl + LDS_STAGE);
    if (threadIdx.x < 4) xst[threadIdx.x] = 0u;
    __syncthreads();
    const XcdBarrier xbar = xcd_barrier_post((unsigned*)(ws + OFF_BAR), xst);

#ifndef NO_P0
    phase0(p, (unsigned*)lds);
#endif
    grid.sync();
    xcd_barrier_census(xbar);
#define GSYNC() xcd_barrier(xbar)

#define FRESH() unsigned char* ws = lnd(p.ws); float* out = lnd(p.out); float* stats = (float*)(ws + OFF_STATS); const float* vec = (const float*)(ws + OFF_VEC); \
    h16* XH = (h16*)(ws + OFF_XH); h16* ZH = (h16*)(ws + OFF_R + 4 * SZ_ACT); (void)out; (void)stats; (void)vec; (void)XH; (void)ZH
    for (int l = 0; l < 2; ++l) {
        if (l == 0) {
            { FRESH(); pg8::Gemm g{XH, (const h16*)(ws + OFF_WIN), NT, 4096, DM}; pg8::StaticOrder S; S.init(NT, 4096, G, bid);
              pg8::EpiProj E{(h16*)(ws + OFF_R), (h16*)(ws + OFF_R + SZ_ACT)};
#ifndef NO_PROJ
              pg8::gemm_phase(ldsl, g, S, E);
#endif
            }
            GSYNC();
#ifndef NO_LRU
            lru_local_phase(p, lds);
#endif
            GSYNC();
            lru_carry_phase(p);
            GSYNC();
            lru_fixup_phase(p);
            GSYNC();
        } else {
            { FRESH(); pg8::Gemm g{XH, (const h16*)(ws + OFF_WQKV), NT, NQKV, DM}; pg8::StaticOrder S; S.init(NT, NQKV, G, bid);
              pg8::EpiQKV E{(h16*)(ws + OFF_R), (h16*)(ws + OFF_R + SZ_ACT), (h16*)(ws + OFF_R + SZ_ACT + (size_t)NT * 512 * 2), stats + (size_t)1 * NT * 2, vec + VEC_QKV, vec + VEC_QKV + 3072, (LAS float*)(ldsl + LDS_VEC)};
#ifndef NO_QKV
              pg8::gemm_phase(ldsl, g, S, E);
#endif
            }
            GSYNC();
#ifndef NO_ATT
            attn_phase(p, lds);
#endif
            GSYNC();
        }
        {
            FRESH(); const float* lg = lnd(p.ln_g); const float* lb = lnd(p.ln_b);
            pg8::Gemm g{XH, (const h16*)(ws + (l == 0 ? OFF_WOUT0 : OFF_WAO)), NT, DM, DM}; pg8::StaticOrder S; S.init(NT, DM, G, bid);
            pg8::EpiRes E{l == 0 ? p.x_prompt : out, l == 0 ? p.x_sample : out + (size_t)8192 * DM, out,
                          l == 0 ? nullptr : stats + (size_t)1 * NT * 2, lg + 1 * DM, lb + 1 * DM,
                          lg + (l * 2) * DM, ZH, stats + (size_t)(l * 2) * NT * 2, (LAS float*)(ldsl + LDS_VEC), nullptr};
#ifndef NO_RES1
            pg8::gemm_phase(ldsl, g, S, E);
#endif
        }
        GSYNC();
        { FRESH(); pg8::Gemm g{ZH, (const h16*)(ws + (l == 0 ? OFF_WGU0 : OFF_WGU1)), NT, 2 * DFF, DM}; pg8::StaticOrder S; S.init(NT, 2 * DFF, G, bid);
          pg8::EpiGU E{(h16*)(ws + OFF_R), stats + (size_t)(l * 2) * NT * 2, vec + (l == 0 ? VEC_GU0 : VEC_GU1), vec + (l == 0 ? VEC_GU0 : VEC_GU1) + 11264, (LAS float*)(ldsl + LDS_VEC)};
#ifndef NO_GU
          pg8::gemm_phase(ldsl, g, S, E);
#endif
        }
        GSYNC();
        {
            FRESH(); const float* lg = lnd(p.ln_g); const float* lb = lnd(p.ln_b);
            pg8::Gemm g{(const h16*)(ws + OFF_R), (const h16*)(ws + (l == 0 ? OFF_WDN0 : OFF_WDN1)), NT, DM, DFF}; pg8::StaticOrder S; S.init(NT, DM, G, bid);
            pg8::EpiRes E{out, out + (size_t)8192 * DM, out, stats + (size_t)(l * 2) * NT * 2, lg + (l * 2) * DM, lb + (l * 2) * DM,
                          lg + (l * 2 + 1) * DM, l == 0 ? XH : nullptr, stats + (size_t)(l * 2 + 1) * NT * 2, (LAS float*)(ldsl + LDS_VEC), l == 0 ? nullptr : XH};
#ifndef NO_RES2
            pg8::gemm_phase(ldsl, g, S, E);
#endif
        }
        GSYNC();
    }
    ln_final_phase((const h16*)(lnd(p.ws) + OFF_XH), p.ln_g + 3 * DM, p.ln_b + 3 * DM, p.out);
}

extern "C" void kernel_launch(void* const* d_in, const int* in_sizes, int n_in, void* d_out, int out_size, void* d_ws, size_t ws_size, hipStream_t stream) {
    static int grid_blocks = 0;
    if (grid_blocks == 0) {
        if (n_in != 17 || out_size != NT * DM || ws_size < WS_END) { fprintf(stderr, "kernel_launch: unexpected shapes (n_in %d out %d ws %zu need %zu)\n", n_in, out_size, ws_size, (size_t)WS_END); grid_blocks = -1; return; }
        if (hipFuncSetAttribute((const void*)mega_fwd, hipFuncAttributeMaxDynamicSharedMemorySize, LDS_BYTES) != hipSuccess) { fprintf(stderr, "kernel_launch: hipFuncSetAttribute failed\n"); grid_blocks = -1; return; }
        int dev = 0, cus = 0, per_cu = 0;
        hipGetDevice(&dev); hipDeviceGetAttribute(&cus, hipDeviceAttributeMultiprocessorCount, dev);
        hipOccupancyMaxActiveBlocksPerMultiprocessor(&per_cu, (const void*)mega_fwd, 512, LDS_BYTES);
        if (per_cu < 1) { fprintf(stderr, "kernel_launch: occupancy query says %d blocks/CU\n", per_cu); }
        (void)hipGetLastError();
        grid_blocks = 256;
        if (cus < 256) { fprintf(stderr, "kernel_launch: %d CUs < 256\n", cus); grid_blocks = -1; return; }
    }
    if (grid_blocks < 0) return;
    Params p{};
    const float** pp = (const float**)&p;
    for (int i = 0; i < 17; ++i) pp[i] = (const float*)d_in[i];
    p.out = (float*)d_out; p.ws = (unsigned char*)d_ws;
    if (hipMemsetAsync((unsigned char*)d_ws + OFF_BAR, 0, ZERO_BYTES, stream) != hipSuccess) { fprintf(stderr, "kernel_launch: memset of barrier words failed\n"); return; }
    void* args[] = {&p};
    hipError_t e = hipLaunchCooperativeKernel((const void*)mega_fwd, dim3(grid_blocks), dim3(512), args, LDS_BYTES, stream);
    if (e != hipSuccess) fprintf(stderr, "kernel_launch: cooperative launch failed: %s\n", hipGetErrorString(e));
}
```

```cpp
#include <hip/hip_runtime.h>
#include <hip/hip_cooperative_groups.h>
#include <cstdio>
namespace cg = cooperative_groups;

#define LAS __attribute__((address_space(3)))
typedef _Float16 h16;
typedef _Float16 f16x8 __attribute__((ext_vector_type(8)));
typedef _Float16 f16x4 __attribute__((ext_vector_type(4)));
typedef _Float16 f16x2 __attribute__((ext_vector_type(2)));
typedef float f32x4 __attribute__((ext_vector_type(4)));
typedef float f32x2 __attribute__((ext_vector_type(2)));
typedef unsigned u32x4 __attribute__((ext_vector_type(4)));
typedef unsigned u32x2 __attribute__((ext_vector_type(2)));

constexpr int NT = 16384, DM = 2048, DFF = 5632, NQKV = 3072;
constexpr float ALPHA = 1.41421356237309515f;
constexpr float LN_EPS = 1e-5f;
constexpr int LDS_STAGE = 131072, LDS_VEC = LDS_STAGE + 16, LDS_BYTES = LDS_VEC + 16384;

constexpr size_t SZ_WIN = (size_t)4096 * 2048 * 2, SZ_WSQ = (size_t)2048 * 2048 * 2, SZ_WGU = (size_t)11264 * 2048 * 2, SZ_WDN = (size_t)2048 * 5632 * 2, SZ_WQKV = (size_t)3072 * 2048 * 2;
constexpr size_t OFF_WIN = 0, OFF_WOUT0 = OFF_WIN + SZ_WIN, OFF_WGU0 = OFF_WOUT0 + SZ_WSQ, OFF_WDN0 = OFF_WGU0 + SZ_WGU, OFF_WQKV = OFF_WDN0 + SZ_WDN,
                 OFF_WAO = OFF_WQKV + SZ_WQKV, OFF_WGU1 = OFF_WAO + SZ_WSQ, OFF_WDN1 = OFF_WGU1 + SZ_WGU, OFF_GT = OFF_WDN1 + SZ_WDN;
constexpr size_t SZ_GT = (size_t)16 * 4 * 128 * 128 * 2, SZ_AGG = (size_t)512 * 2 * 2048 * 4;
constexpr size_t OFF_AGGA = OFF_GT + SZ_GT, OFF_AGGH = OFF_AGGA + SZ_AGG, OFF_CARRY = OFF_AGGH + SZ_AGG, OFF_BAR = OFF_CARRY + SZ_AGG, OFF_STATS = OFF_BAR + 16384, OFF_VEC = OFF_STATS + 524288, OFF_XH = OFF_VEC + 262144;
constexpr size_t ZERO_BYTES = 16384 + 524288 + 262144;
constexpr int VEC_GU0 = 0, VEC_GU1 = 2 * 11264, VEC_QKV = 4 * 11264;
constexpr size_t SZ_ACT = (size_t)NT * DM * 2;
constexpr size_t OFF_R = OFF_XH + SZ_ACT;
constexpr size_t WS_END = OFF_R + 5 * SZ_ACT;

struct Params {
    const float *x_prompt, *x_sample, *lru_w_in, *lru_conv_w, *lru_conv_b, *lru_gate_w, *lru_gate_b, *lru_lambda, *lru_w_out,
                *attn_w_qkv, *attn_sink, *attn_w_out, *rel_bias, *ffn_w_gu, *ffn_w_down, *ln_g, *ln_b;
    float* out; unsigned char* ws;
};

template <class T> __device__ __forceinline__ T* lnd(T* p) { asm volatile("" : "+s"(p)); return p; }
__device__ __forceinline__ int lnd_tid() { int t = threadIdx.x; asm volatile("" : "+v"(t)); return t; }
#define GAS __attribute__((address_space(1)))
__device__ __forceinline__ f32x4 ldg4(const float* p) { return *(const GAS f32x4*)(p); }
__device__ __forceinline__ f32x2 ldg2(const float* p) { return *(const GAS f32x2*)(p); }
__device__ __forceinline__ void stg4(float* p, f32x4 v) { *(GAS f32x4*)p = v; }
__device__ __forceinline__ void stg4h(h16* p, u32x4 v) { *(GAS u32x4*)p = v; }
__device__ __forceinline__ void lds_barrier() { asm volatile("s_waitcnt lgkmcnt(0)\n\ts_barrier" ::: "memory"); }
__device__ __forceinline__ unsigned pk2(float a, float b) { f16x2 v; v.x = (h16)a; v.y = (h16)b; return __builtin_bit_cast(unsigned, v); }
__device__ __forceinline__ float fast_rcp(float x) { return __builtin_amdgcn_rcpf(x); }
__device__ __forceinline__ float sigmoidf_(float x) { return fast_rcp(1.0f + __expf(-x)); }
__device__ __forceinline__ float gelu_tanh(float x) { const float y = 1.5957691216057308f * (x + 0.044715f * x * x * x); return x * fast_rcp(1.0f + __expf(-y)); }
__device__ __forceinline__ float silu_(float x) { return x * fast_rcp(1.0f + __expf(-x)); }
__device__ __forceinline__ void seq_bounds(int t, int& s0, int& s1) { if (t < 8192) { s0 = 0; s1 = 8192; } else { s0 = 8192 + ((t - 8192) >> 11 << 11); s1 = s0 + 2048; } }

namespace pg8 {
constexpr int BM = 256, BK = 64, HALF = 128, HTB = HALF * BK * 2, NXCD = 8, WGM = 8;
__device__ __forceinline__ int lds_byte(int r, int c) { const int st = (r >> 4) * 2 + (c >> 5), rr = r & 15, cc = c & 31, ob = rr * 64 + cc * 2; return st * 1024 + (ob ^ (((ob >> 9) & 1) << 5)); }
__device__ __forceinline__ void stage_rc(int b, int& R, int& C) { const int st = b / 1024, sb = b % 1024, swz = sb ^ (((sb >> 9) & 1) << 5); R = (st >> 1) * 16 + swz / 64; C = (st & 1) * 32 + (swz % 64) / 2; }
__device__ __forceinline__ int perm32(int rho) { const int n = rho >> 4, i = rho & 15; return 8 * (i >> 2) + 4 * n + (i & 3); }
struct Unit { int pm, pn; };
struct Gemm { const h16* A; const h16* Bt; int M, N, K; };
struct StaticOrder {
    int nM, nN, nwg, G, c;
    __device__ void init(int M, int N, int G_, int c_) { nM = M / BM; nN = N / BM; nwg = nM * nN; G = G_; c = c_; }
    __device__ bool next(int i, Unit& u) const {
        const long L = (long)i * G + c; if (L >= nwg) return false;
        int wgid = (int)L; { const int q = nwg / NXCD, r = nwg % NXCD, xcd = wgid % NXCD, off = wgid / NXCD; wgid = (xcd < r ? xcd * (q + 1) : r * (q + 1) + (xcd - r) * q) + off; }
        const int nig = WGM * nN, gid = wgid / nig, fm = gid * WGM, gsz = (nM - fm) < WGM ? (nM - fm) : WGM;
        u.pm = fm + ((wgid % nig) % gsz); u.pn = (wgid % nig) / gsz; return true;
    }
};


__device__ __forceinline__ void row_mu_rstd(const float* stats, int row, float& mu, float& rs) {
    const f32x2 st = ldg2(stats + 2 * (size_t)row); mu = st.x * (1.0f / DM); rs = rsqrtf(fmaxf(st.y * (1.0f / DM) - mu * mu, 0.f) + LN_EPS); }
__device__ __forceinline__ void rows_mu_rstd(const float* stats, int row0, float (&mu)[2][4], float (&rs)[2][4]) {
    f32x2 st[8];
#pragma unroll
    for (int i = 0; i < 8; ++i) st[i] = ldg2(stats + 2 * (size_t)(row0 + (i >> 2) * 128 + (i & 3) * 16));
    asm volatile("" : "+v"(st[0].x), "+v"(st[0].y), "+v"(st[1].x), "+v"(st[1].y), "+v"(st[2].x), "+v"(st[2].y), "+v"(st[3].x), "+v"(st[3].y),
                      "+v"(st[4].x), "+v"(st[4].y), "+v"(st[5].x), "+v"(st[5].y), "+v"(st[6].x), "+v"(st[6].y), "+v"(st[7].x), "+v"(st[7].y));
#pragma unroll
    for (int i = 0; i < 8; ++i) { const float m_ = st[i].x * (1.0f / DM); mu[i >> 2][i & 3] = m_; rs[i >> 2][i & 3] = rsqrtf(fmaxf(st[i].y * (1.0f / DM) - m_ * m_, 0.f) + LN_EPS); }
}
__device__ __forceinline__ void lnfold_prefetch(LAS float* vl, const float* stats, const float* gW, const float* bW, const Unit& u, int wr, int wc, int lane) {
    LAS float* slot = vl + (wr * 4 + wc) * 512;
    const int rowb = u.pm * BM + wr * 64 + (lane >> 5) * HALF + (lane & 31) * 2;
    const int col = u.pn * BM + wc * 32 + (lane < 32 ? lane : 96 + lane);
    __builtin_amdgcn_global_load_lds((const unsigned*)(stats + 2 * (size_t)rowb), (LAS unsigned*)slot, 16, 0, 0);
    __builtin_amdgcn_global_load_lds((const unsigned*)(gW + col), (LAS unsigned*)(slot + 256), 4, 0, 0);
    __builtin_amdgcn_global_load_lds((const unsigned*)(bW + col), (LAS unsigned*)(slot + 320), 4, 0, 0);
}
__device__ __forceinline__ void lnfold_rows(const LAS float* slot, int fr, float (&mu)[2][4], float (&rs)[2][4]) {
#pragma unroll
    for (int i = 0; i < 8; ++i) { const f32x2 st = *(const LAS f32x2*)(slot + 2 * ((i >> 2) * 64 + (i & 3) * 16 + fr));
        const float m_ = st.x * (1.0f / DM); mu[i >> 2][i & 3] = m_; rs[i >> 2][i & 3] = rsqrtf(fmaxf(st.y * (1.0f / DM) - m_ * m_, 0.f) + LN_EPS); }
}
struct EpiRes {
    static constexpr bool PERM = true, PREF = false;
    __device__ __forceinline__ void prefetch(const Unit&, int, int, int) const {}
    const float* res0; const float* res1; float* out;
    const float* pstats; const float* pg; const float* pb;
    const float* tg; h16* zh; float* tstats;
    LAS float* vl;
    h16* zf;
    __device__ __forceinline__ const float* resrow(int row, int colb) const { return (row < 8192 ? res0 + (size_t)row * DM : res1 + (size_t)(row - 8192) * DM) + colb; }
    __device__ __forceinline__ void operator()(f32x4 (&acc)[2][2][4][2], const Unit& u, int wr, int wc, int fr, int fq) const {
        const int row0 = u.pm * BM + wr * 64 + fr, colb = u.pn * BM + wc * 32 + 8 * fq;
        const bool hasln = pstats != nullptr, haszh = zh != nullptr;
        LAS float* slot = vl + (wr * 4 + wc) * 256;
        f32x4 rn[2][2]; float ssm[8], ssq[8]; f32x2 stn = {0.f, 0.f};
        { const int lane = fr + 16 * fq, cL = u.pn * BM + wc * 32 + (lane < 32 ? lane : 96 + lane);
          float vg = 0.f, vb = 0.f, vt = 0.f;
          if (hasln) { vg = *(const GAS float*)(pg + cL); vb = *(const GAS float*)(pb + cL); }
          if (haszh) vt = *(const GAS float*)(tg + cL);
          const float* rp = resrow(row0, colb);
#pragma unroll
          for (int bj = 0; bj < 2; ++bj) { rn[bj][0] = ldg4(rp + bj * HALF); rn[bj][1] = ldg4(rp + bj * HALF + 4); }
          if (hasln) stn = ldg2(pstats + 2 * (size_t)row0);
          asm volatile("" : "+v"(vg), "+v"(vb), "+v"(vt), "+v"(rn[0][0]), "+v"(rn[0][1]), "+v"(rn[1][0]), "+v"(rn[1][1]), "+v"(stn));
          slot[lane] = vg; slot[64 + lane] = vb; slot[128 + lane] = vt;
        }
#pragma unroll
        for (int ai = 0; ai < 2; ++ai)
#pragma unroll
            for (int m = 0; m < 4; ++m) {
                const int row = row0 + ai * HALF + m * 16;
                f32x4 r[2][2]; const f32x2 st = stn;
#pragma unroll
                for (int bj = 0; bj < 2; ++bj) { r[bj][0] = rn[bj][0]; r[bj][1] = rn[bj][1]; }
                if (ai * 4 + m < 7) { const int rown = row0 + ((ai * 4 + m + 1) >> 2) * HALF + ((ai * 4 + m + 1) & 3) * 16; const float* rp = resrow(rown, colb);
#pragma unroll
                    for (int bj = 0; bj < 2; ++bj) { rn[bj][0] = ldg4(rp + bj * HALF); rn[bj][1] = ldg4(rp + bj * HALF + 4); }
                    if (hasln) stn = ldg2(pstats + 2 * (size_t)rown);
                }
                float* op = out + (size_t)row * DM + colb; h16* zp = zh + (size_t)row * DM + colb;
                float mu = 0.f, rs = 1.f; if (hasln) { mu = st.x * (1.0f / DM); rs = rsqrtf(fmaxf(st.y * (1.0f / DM) - mu * mu, 0.f) + LN_EPS); }
                float sm = 0.f, sq = 0.f;
#pragma unroll
                for (int bj = 0; bj < 2; ++bj) {
                    f32x4 r0 = r[bj][0], r1 = r[bj][1];
                    if (hasln) { const f32x4 g0 = *(const LAS f32x4*)(slot + bj * 32 + 8 * fq), g1 = *(const LAS f32x4*)(slot + bj * 32 + 8 * fq + 4),
                                             b0 = *(const LAS f32x4*)(slot + 64 + bj * 32 + 8 * fq), b1 = *(const LAS f32x4*)(slot + 64 + bj * 32 + 8 * fq + 4);
                        r0 = (r0 - mu) * rs * g0 + b0; r1 = (r1 - mu) * rs * g1 + b1; }
                    const f32x4 z0 = r0 * ALPHA + acc[ai][bj][m][0], z1 = r1 * ALPHA + acc[ai][bj][m][1];
                    if (zf == nullptr) { stg4(op + bj * HALF, z0); stg4(op + bj * HALF + 4, z1); }
                    else { u32x4 w; w.x = pk2(z0[0], z0[1]); w.y = pk2(z0[2], z0[3]); w.z = pk2(z1[0], z1[1]); w.w = pk2(z1[2], z1[3]); stg4h(zf + (size_t)row * DM + colb + bj * HALF, w); }
                    sm += ((z0[0] + z0[1]) + (z0[2] + z0[3])) + ((z1[0] + z1[1]) + (z1[2] + z1[3]));
                    sq += ((z0[0] * z0[0] + z0[1] * z0[1]) + (z0[2] * z0[2] + z0[3] * z0[3])) + ((z1[0] * z1[0] + z1[1] * z1[1]) + (z1[2] * z1[2] + z1[3] * z1[3]));
                    if (haszh) {
                        const f32x4 t0 = *(const LAS f32x4*)(slot + 128 + bj * 32 + 8 * fq), t1 = *(const LAS f32x4*)(slot + 128 + bj * 32 + 8 * fq + 4);
                        const f32x4 y0 = z0 * t0, y1 = z1 * t1;
                        u32x4 w; w.x = pk2(y0[0], y0[1]); w.y = pk2(y0[2], y0[3]); w.z = pk2(y1[0], y1[1]); w.w = pk2(y1[2], y1[3]);
                        stg4h(zp + bj * HALF, w); }
                }
                sm += __shfl_xor(sm, 16); sm += __shfl_xor(sm, 32); sq += __shfl_xor(sq, 16); sq += __shfl_xor(sq, 32);
                ssm[ai * 4 + m] = sm; ssq[ai * 4 + m] = sq;
                asm volatile("" ::: "memory");
            }
        if (haszh) {
#pragma unroll
            for (int ai = 0; ai < 2; ++ai)
#pragma unroll
                for (int mp = 0; mp < 2; ++mp) {
                    const float lo = (fq & 1) ? ssq[ai * 4 + 2 * mp] : ssm[ai * 4 + 2 * mp], hi = (fq & 1) ? ssq[ai * 4 + 2 * mp + 1] : ssm[ai * 4 + 2 * mp + 1];
                    const float v = (fq & 2) ? hi : lo; const size_t row = (size_t)(row0 + ai * HALF + (2 * mp + (fq >> 1)) * 16);
                    __hip_atomic_fetch_add((GAS float*)(tstats + 2 * row + (fq & 1)), v, __ATOMIC_RELAXED, __HIP_MEMORY_SCOPE_AGENT);
                }
        }
    }
};
struct EpiProj {
    static constexpr bool PERM = true, PREF = false;
    __device__ __forceinline__ void prefetch(const Unit&, int, int, int) const {}
    h16* ybr; h16* xpre;
    __device__ __forceinline__ void operator()(f32x4 (&acc)[2][2][4][2], const Unit& u, int wr, int wc, int fr, int fq) const {
        const bool isy = u.pn < 8; h16* dst = isy ? ybr : xpre; const int colb = (isy ? u.pn : u.pn - 8) * BM + wc * 32 + 8 * fq;
        const int row0 = u.pm * BM + wr * 64 + fr;
#pragma unroll
        for (int ai = 0; ai < 2; ++ai)
#pragma unroll
            for (int m = 0; m < 4; ++m) { h16* rowp = dst + (size_t)(row0 + ai * HALF + m * 16) * DM + colb;
#pragma unroll
                for (int bj = 0; bj < 2; ++bj) { f32x4 v0 = acc[ai][bj][m][0], v1 = acc[ai][bj][m][1];
                    if (isy) {
#pragma unroll
                        for (int j = 0; j < 4; ++j) { v0[j] = gelu_tanh(v0[j]); v1[j] = gelu_tanh(v1[j]); } }
                    u32x4 w; w.x = pk2(v0[0], v0[1]); w.y = pk2(v0[2], v0[3]); w.z = pk2(v1[0], v1[1]); w.w = pk2(v1[2], v1[3]);
                    stg4h(rowp + bj * HALF, w);  } }
    }
};
struct EpiGU {
    static constexpr bool PERM = true, PREF = true;
    h16* act; const float* stats; const float* gW; const float* bW; LAS float* vl;
    __device__ __forceinline__ void prefetch(const Unit& u, int wr, int wc, int lane) const { lnfold_prefetch(vl, stats, gW, bW, u, wr, wc, lane); }
    __device__ __forceinline__ void operator()(f32x4 (&acc)[2][2][4][2], const Unit& u, int wr, int wc, int fr, int fq) const {
        const int row0 = u.pm * BM + wr * 64 + fr, colb = u.pn * HALF + wc * 32 + 8 * fq, vb = u.pn * BM + wc * 32 + 8 * fq;
        float mu[2][4], rs[2][4]; f32x4 wg[2], wu[2], cg_[2], cu[2];
        const LAS float* slot = vl + (wr * 4 + wc) * 512;
#pragma unroll
        for (int n = 0; n < 2; ++n) { wg[n] = *(const LAS f32x4*)(slot + 256 + 8 * fq + 4 * n); wu[n] = *(const LAS f32x4*)(slot + 288 + 8 * fq + 4 * n);
                                      cg_[n] = *(const LAS f32x4*)(slot + 320 + 8 * fq + 4 * n); cu[n] = *(const LAS f32x4*)(slot + 352 + 8 * fq + 4 * n); }
        lnfold_rows(slot, fr, mu, rs); (void)vb;
#pragma unroll
        for (int ai = 0; ai < 2; ++ai)
#pragma unroll
            for (int m = 0; m < 4; ++m) { const int row = row0 + ai * HALF + m * 16; h16* rowp = act + (size_t)row * DFF + colb;
                float a[8];
#pragma unroll
                for (int n = 0; n < 2; ++n) {
                    const f32x4 gv = (acc[ai][0][m][n] - mu[ai][m] * wg[n]) * rs[ai][m] + cg_[n], uv = (acc[ai][1][m][n] - mu[ai][m] * wu[n]) * rs[ai][m] + cu[n];
#pragma unroll
                    for (int j = 0; j < 4; ++j) a[4 * n + j] = silu_(gv[j]) * uv[j];
                }
                u32x4 w; w.x = pk2(a[0], a[1]); w.y = pk2(a[2], a[3]); w.z = pk2(a[4], a[5]); w.w = pk2(a[6], a[7]);
                stg4h(rowp, w); }
    }
};
struct EpiQKV {
    static constexpr bool PERM = true, PREF = true;
    h16* q; h16* k; h16* vT; const float* stats; const float* gW; const float* bW; LAS float* vl;
    __device__ __forceinline__ void prefetch(const Unit& u, int wr, int wc, int lane) const { lnfold_prefetch(vl, stats, gW, bW, u, wr, wc, lane); }
    __device__ __forceinline__ void operator()(f32x4 (&acc)[2][2][4][2], const Unit& u, int wr, int wc, int fr, int fq) const {
        const int row0 = u.pm * BM + wr * 64 + fr, vb = u.pn * BM + wc * 32 + 8 * fq;
        {
            float mu[2][4], rs[2][4]; f32x4 w[2][2], c[2][2];
            const LAS float* slot = vl + (wr * 4 + wc) * 512;
            lnfold_rows(slot, fr, mu, rs); (void)vb;
#pragma unroll
            for (int bj = 0; bj < 2; ++bj)
#pragma unroll
                for (int n = 0; n < 2; ++n) { w[bj][n] = *(const LAS f32x4*)(slot + 256 + bj * 32 + 8 * fq + 4 * n); c[bj][n] = *(const LAS f32x4*)(slot + 320 + bj * 32 + 8 * fq + 4 * n); }
            if (u.pn < 8) {
                const float qs = 0.08838834764831845f * 1.4426950408889634f;
#pragma unroll
                for (int i = 0; i < 8; ++i) rs[i >> 2][i & 3] *= qs;
#pragma unroll
                for (int bj = 0; bj < 2; ++bj)
#pragma unroll
                    for (int n = 0; n < 2; ++n) c[bj][n] *= qs;
            }
#pragma unroll
            for (int ai = 0; ai < 2; ++ai)
#pragma unroll
                for (int m = 0; m < 4; ++m)
#pragma unroll
                    for (int bj = 0; bj < 2; ++bj)
#pragma unroll
                        for (int n = 0; n < 2; ++n) acc[ai][bj][m][n] = (acc[ai][bj][m][n] - mu[ai][m] * w[bj][n]) * rs[ai][m] + c[bj][n];
        }
        if (u.pn < 10) {
            const bool isq = u.pn < 8; h16* dst = isq ? q : k; const int ld = isq ? 2048 : 512; const int colb = (isq ? u.pn : u.pn - 8) * BM + wc * 32 + 8 * fq;
#pragma unroll
            for (int ai = 0; ai < 2; ++ai)
#pragma unroll
                for (int m = 0; m < 4; ++m) { h16* rowp = dst + (size_t)(row0 + ai * HALF + m * 16) * ld + colb;
#pragma unroll
                    for (int bj = 0; bj < 2; ++bj) { const f32x4 v0 = acc[ai][bj][m][0], v1 = acc[ai][bj][m][1];
                        u32x4 w; w.x = pk2(v0[0], v0[1]); w.y = pk2(v0[2], v0[3]); w.z = pk2(v1[0], v1[1]); w.w = pk2(v1[2], v1[3]);
                        stg4h(rowp + bj * HALF, w); } }
        } else {
            const int colb = (u.pn - 10) * BM + wc * 32 + 8 * fq;
#pragma unroll
            for (int ai = 0; ai < 2; ++ai)
#pragma unroll
                for (int m = 0; m < 4; ++m) { const int row = row0 + ai * HALF + m * 16;
#pragma unroll
                    for (int bj = 0; bj < 2; ++bj)
#pragma unroll
                        for (int n = 0; n < 2; ++n)
#pragma unroll
                            for (int j = 0; j < 4; ++j) *(GAS h16*)(vT + (size_t)(colb + bj * HALF + 4 * n + j) * NT + row) = (h16)acc[ai][bj][m][n][j];
                    asm volatile("" ::: "memory"); }
        }
    }
};

template <class Epi>
__device__ __forceinline__ void gemm_phase(LAS unsigned char* lds, const Gemm g0, const StaticOrder& S, const Epi& E) {
    Gemm g = g0; g.A = lnd(g.A); g.Bt = lnd(g.Bt);
    const int tid = lnd_tid(), wid = __builtin_amdgcn_readfirstlane(tid >> 6), lane = tid & 63, wr = wid >> 2, wc = wid & 3, fr = lane & 15, fq = lane >> 4;
    const int K = g.K, nt = K / BK;
    unsigned voffA[2], voffB[2];
#pragma unroll
    for (int i = 0; i < 2; ++i) { int R, C; stage_rc(tid * 16 + i * 8192, R, C); const int Rb = Epi::PERM ? ((R & ~31) + perm32(R & 31)) : R;
        voffA[i] = (unsigned)(R * K + C) * 2u; voffB[i] = (unsigned)(Rb * K + C) * 2u; }
    const size_t kstep = (size_t)(BK * 2);
    const size_t hstep = (size_t)HALF * K * 2;
    const size_t tstep = 2 * hstep;
    const unsigned ldsw = (unsigned)wid * 1024u;
    const int aoff = lds_byte(wr * 64 + fr, fq * 8), boff = lds_byte(wc * 32 + fr, fq * 8);
#define PG8_SA(b, h) (((b) * 2 + (h)) * HTB)
#define PG8_SB(b, h) ((4 + (b) * 2 + (h)) * HTB)
#define PG8_STAGE(bufoff, gbase, voff) do { _Pragma("unroll") for (int _i = 0; _i < 2; ++_i) \
        __builtin_amdgcn_global_load_lds((const unsigned*)((const char*)(gbase) + (voff)[_i]), (LAS unsigned*)(lds + (bufoff) + ldsw + _i * 8192), 16, 0, 0); } while (0)
#define PG8_LDA(dst, b, h) do { _Pragma("unroll") for (int m = 0; m < 4; ++m) _Pragma("unroll") for (int k = 0; k < 2; ++k) dst[m][k] = *(const LAS f16x8*)(lds + PG8_SA(b, h) + aoff + m * 2048 + k * 1024); } while (0)
#define PG8_LDB(dst, b, h) do { _Pragma("unroll") for (int n = 0; n < 2; ++n) _Pragma("unroll") for (int k = 0; k < 2; ++k) dst[n][k] = *(const LAS f16x8*)(lds + PG8_SB(b, h) + boff + n * 2048 + k * 1024); } while (0)
#define PG8_MMA(ai, bj, At, Bt) do { __builtin_amdgcn_s_setprio(1); _Pragma("unroll") for (int m = 0; m < 4; ++m) _Pragma("unroll") for (int n = 0; n < 2; ++n) _Pragma("unroll") for (int k = 0; k < 2; ++k) \
        acc[ai][bj][m][n] = __builtin_amdgcn_mfma_f32_16x16x32_f16(Bt[n][k], At[m][k], acc[ai][bj][m][n], 0, 0, 0); __builtin_amdgcn_s_setprio(0); } while (0)
#define PG8_WAIT_V(n) asm volatile("s_waitcnt vmcnt(" #n ")" ::: "memory")
#define PG8_WAIT_L(n) asm volatile("s_waitcnt lgkmcnt(" #n ")" ::: "memory")
#define PG8_BAR __builtin_amdgcn_s_barrier()
#define PG8_SCHED __builtin_amdgcn_sched_barrier(0)
    Unit cur, nxt; int ui = 0;
    if (!S.next(0, cur)) return;
    f32x4 acc[2][2][4][2];
#pragma unroll
    for (int a = 0; a < 2; ++a)
#pragma unroll
        for (int b = 0; b < 2; ++b)
#pragma unroll
            for (int m = 0; m < 4; ++m)
#pragma unroll
                for (int n = 0; n < 2; ++n) acc[a][b][m][n] = (f32x4){0.f, 0.f, 0.f, 0.f};
    f16x8 At[4][2], B0[2][2], B1[2][2];
    const char* cA = (const char*)g.A + (size_t)cur.pm * tstep; const char* cB = (const char*)g.Bt + (size_t)cur.pn * tstep;
    PG8_STAGE(PG8_SB(0, 0), cB, voffB); PG8_STAGE(PG8_SA(0, 0), cA, voffA); PG8_STAGE(PG8_SB(0, 1), cB + hstep, voffB); PG8_STAGE(PG8_SA(0, 1), cA + hstep, voffA);
    if (wr == 1) PG8_BAR;
    PG8_WAIT_V(4); PG8_BAR;
    PG8_STAGE(PG8_SB(1, 0), cB + kstep, voffB); PG8_STAGE(PG8_SA(1, 0), cA + kstep, voffA); PG8_STAGE(PG8_SB(1, 1), cB + hstep + kstep, voffB);
    PG8_WAIT_V(6); PG8_BAR;
    for (;;) {
        const bool has_next = S.next(ui + 1, nxt);
        const char* nA = has_next ? (const char*)g.A + (size_t)nxt.pm * tstep : cA; const char* nB = has_next ? (const char*)g.Bt + (size_t)nxt.pn * tstep : cB;
        for (int t = 0; t < nt; t += 2) {
            const bool last = (t == nt - 2);
            if (Epi::PREF && last) E.prefetch(cur, wr, wc, lane);
            const char* a1 = cA + (size_t)(t + 1) * kstep;
            const char* a2 = last ? nA : cA + (size_t)(t + 2) * kstep; const char* b2 = last ? nB : cB + (size_t)(t + 2) * kstep;
            const char* a3 = a2 + kstep; const char* b3 = b2 + kstep;
            PG8_LDB(B0, 0, 0); PG8_SCHED; PG8_LDA(At, 0, 0); PG8_STAGE(PG8_SA(1, 1), a1 + hstep, voffA);
            PG8_WAIT_L(8); PG8_BAR; PG8_WAIT_L(0); PG8_MMA(0, 0, At, B0); PG8_BAR; PG8_SCHED;
            PG8_LDB(B1, 0, 1); PG8_STAGE(PG8_SB(0, 0), b2, voffB);
            PG8_BAR; PG8_WAIT_L(0); PG8_MMA(0, 1, At, B1); PG8_BAR;
            PG8_LDA(At, 0, 1); PG8_STAGE(PG8_SA(0, 0), a2, voffA);
            PG8_BAR; PG8_WAIT_L(0); PG8_MMA(1, 0, At, B0); PG8_BAR; PG8_SCHED;
            PG8_STAGE(PG8_SB(0, 1), b2 + hstep, voffB);
            PG8_WAIT_V(6); PG8_BAR; PG8_MMA(1, 1, At, B1); PG8_BAR;
            PG8_LDB(B0, 1, 0); PG8_SCHED; PG8_LDA(At, 1, 0); PG8_STAGE(PG8_SA(0, 1), a2 + hstep, voffA);
            PG8_WAIT_L(8); PG8_BAR; PG8_WAIT_L(0); PG8_MMA(0, 0, At, B0); PG8_BAR; PG8_SCHED;
            PG8_LDB(B1, 1, 1); PG8_STAGE(PG8_SB(1, 0), b3, voffB);
            PG8_BAR; PG8_WAIT_L(0); PG8_MMA(0, 1, At, B1); PG8_BAR;
            PG8_LDA(At, 1, 1); PG8_STAGE(PG8_SA(1, 0), a3, voffA);
            PG8_BAR; PG8_WAIT_L(0); PG8_MMA(1, 0, At, B0); PG8_BAR; PG8_SCHED;
            PG8_STAGE(PG8_SB(1, 1), b3 + hstep, voffB);
            PG8_WAIT_V(6); PG8_BAR; PG8_MMA(1, 1, At, B1); PG8_BAR;
        }
        if (Epi::PREF) asm volatile("s_waitcnt vmcnt(16)" ::: "memory");
        E(acc, cur, wr, wc, fr, fq);
        if (!has_next) break;
#pragma unroll
        for (int a = 0; a < 2; ++a)
#pragma unroll
            for (int b = 0; b < 2; ++b)
#pragma unroll
                for (int m = 0; m < 4; ++m)
#pragma unroll
                    for (int n = 0; n < 2; ++n) acc[a][b][m][n] = (f32x4){0.f, 0.f, 0.f, 0.f};
        cur = nxt; cA = nA; cB = nB; ++ui;
    }
    PG8_WAIT_V(0);
    if (wr == 0) PG8_BAR;
    PG8_BAR;
#undef PG8_SA
#undef PG8_SB
#undef PG8_STAGE
#undef PG8_LDA
#undef PG8_LDB
#undef PG8_MMA
#undef PG8_WAIT_V
#undef PG8_WAIT_L
#undef PG8_BAR
#undef PG8_SCHED
}
}

template <bool LNV>
__device__ __forceinline__ void conv_tile(const float* src, int src_ld, h16* dst, int dst_ld, unsigned* L, const float* gam, const float* bet, float* gW, float* bW) {
    const int tid = lnd_tid(), nq = tid & 15, kp = tid >> 4;
    const f32x4 a = ldg4(src + (size_t)(2 * kp) * src_ld + 4 * nq);
    const f32x4 b = ldg4(src + (size_t)(2 * kp + 1) * src_ld + 4 * nq);
    L[(4 * nq + 0) * 33 + kp] = pk2(a.x, b.x); L[(4 * nq + 1) * 33 + kp] = pk2(a.y, b.y); L[(4 * nq + 2) * 33 + kp] = pk2(a.z, b.z); L[(4 * nq + 3) * 33 + kp] = pk2(a.w, b.w);
    lds_barrier();
    const int n = tid >> 3, c = tid & 7;
    u32x4 v; v.x = L[n * 33 + 4 * c]; v.y = L[n * 33 + 4 * c + 1]; v.z = L[n * 33 + 4 * c + 2]; v.w = L[n * 33 + 4 * c + 3];
    *(GAS u32x4*)(dst + (size_t)n * dst_ld + 8 * c) = v;
    if (LNV) {
        const f16x8 hv = __builtin_bit_cast(f16x8, v);
        const f32x4 g0 = *(const f32x4*)(gam + 8 * c), g1 = *(const f32x4*)(gam + 8 * c + 4), b0 = *(const f32x4*)(bet + 8 * c), b1 = *(const f32x4*)(bet + 8 * c + 4);
        float sg = 0.f, sb = 0.f;
#pragma unroll
        for (int j = 0; j < 4; ++j) { sg += g0[j] * (float)hv[j] + g1[j] * (float)hv[4 + j]; sb += b0[j] * (float)hv[j] + b1[j] * (float)hv[4 + j]; }
        sg += __shfl_xor(sg, 1); sg += __shfl_xor(sg, 2); sg += __shfl_xor(sg, 4); sb += __shfl_xor(sb, 1); sb += __shfl_xor(sb, 2); sb += __shfl_xor(sb, 4);
        if (c == 0) { __hip_atomic_fetch_add((GAS float*)(gW + n), sg, __ATOMIC_RELAXED, __HIP_MEMORY_SCOPE_AGENT); __hip_atomic_fetch_add((GAS float*)(bW + n), sb, __ATOMIC_RELAXED, __HIP_MEMORY_SCOPE_AGENT); }
    }
    lds_barrier();
}
template <int MODE, bool LNV>
__device__ __forceinline__ void conv_matrix(const float* src, int K, int N, h16* dst, unsigned* L, const float* gam, const float* bet, float* gW, float* bW, int& rot) {
    const int nsn = N / 256, ntk = K / 64, total = nsn * ntk, G = gridDim.x;
    const int tid = lnd_tid(), nq = tid & 15, kp = tid >> 4, n = tid >> 3, c = tid & 7;
    f32x4 ra[4], rb[4], rc[4], rd[4];
#define CM_ISSUE(RA, RB, st_) do { const int tk_ = (st_) / nsn, sn_ = (st_) % nsn; _Pragma("unroll") for (int j = 0; j < 4; ++j) { const int n0_ = sn_ * 256 + 64 * j; \
        const int sc_ = MODE ? ((j >> 1) * 5632 + sn_ * 128 + (j & 1) * 64) : n0_; const float* p_ = src + (size_t)(tk_ * 64 + 2 * kp) * N + sc_ + 4 * nq; \
        RA[j] = ldg4(p_); RB[j] = ldg4(p_ + N); } } while (0)
#define CM_STEP(RA, RB, st_) do { const int tk = (st_) / nsn, sn = (st_) % nsn; \
        _Pragma("unroll") for (int j = 0; j < 4; ++j) { unsigned* Lj = L + j * 2112; \
            Lj[(4 * nq + 0) * 33 + kp] = pk2(RA[j].x, RB[j].x); Lj[(4 * nq + 1) * 33 + kp] = pk2(RA[j].y, RB[j].y); Lj[(4 * nq + 2) * 33 + kp] = pk2(RA[j].z, RB[j].z); Lj[(4 * nq + 3) * 33 + kp] = pk2(RA[j].w, RB[j].w); } \
        lds_barrier(); \
        if ((st_) + 2 * G < total) CM_ISSUE(RA, RB, (st_) + 2 * G); \
        f32x4 g0, g1, b0, b1; \
        if (LNV) { g0 = ldg4(gam + tk * 64 + 8 * c); g1 = ldg4(gam + tk * 64 + 8 * c + 4); b0 = ldg4(bet + tk * 64 + 8 * c); b1 = ldg4(bet + tk * 64 + 8 * c + 4); } \
        _Pragma("unroll") for (int j = 0; j < 4; ++j) { const unsigned* Lj = L + j * 2112; const int n0 = sn * 256 + 64 * j; \
            u32x4 v; v.x = Lj[n * 33 + 4 * c]; v.y = Lj[n * 33 + 4 * c + 1]; v.z = Lj[n * 33 + 4 * c + 2]; v.w = Lj[n * 33 + 4 * c + 3]; \
            *(GAS u32x4*)(dst + (size_t)(n0 + n) * K + tk * 64 + 8 * c) = v; \
            if (LNV) { const f16x8 hv = __builtin_bit_cast(f16x8, v); float sg = 0.f, sb = 0.f; \
                _Pragma("unroll") for (int q = 0; q < 4; ++q) { sg += g0[q] * (float)hv[q] + g1[q] * (float)hv[4 + q]; sb += b0[q] * (float)hv[q] + b1[q] * (float)hv[4 + q]; } \
                sg += __shfl_xor(sg, 1); sg += __shfl_xor(sg, 2); sg += __shfl_xor(sg, 4); sb += __shfl_xor(sb, 1); sb += __shfl_xor(sb, 2); sb += __shfl_xor(sb, 4); \
                if (c == 0) { __hip_atomic_fetch_add((GAS float*)(gW + n0 + n), sg, __ATOMIC_RELAXED, __HIP_MEMORY_SCOPE_AGENT); __hip_atomic_fetch_add((GAS float*)(bW + n0 + n), sb, __ATOMIC_RELAXED, __HIP_MEMORY_SCOPE_AGENT); } } } \
        lds_barrier(); } while (0)
    int st = ((int)blockIdx.x - rot + G) % G; rot = (rot + total) % G;
    if (st < total) CM_ISSUE(ra, rb, st);
    if (st + G < total) CM_ISSUE(rc, rd, st + G);
    for (; st < total; st += 2 * G) {
        CM_STEP(ra, rb, st);
        if (st + G < total) CM_STEP(rc, rd, st + G);
    }
#undef CM_STEP
#undef CM_ISSUE
}
__device__ void phase0(const Params& p, unsigned* L) {
    unsigned char* ws = lnd(p.ws);
    float* vec = (float*)(ws + OFF_VEC); int rot = 0;
    conv_matrix<0, false>(p.lru_w_in, 2048, 4096, (h16*)(ws + OFF_WIN), L, nullptr, nullptr, nullptr, nullptr, rot);
    conv_matrix<0, false>(p.lru_w_out, 2048, 2048, (h16*)(ws + OFF_WOUT0), L, nullptr, nullptr, nullptr, nullptr, rot);
    conv_matrix<0, true>(p.attn_w_qkv, 2048, 3072, (h16*)(ws + OFF_WQKV), L, p.ln_g + 1 * DM, p.ln_b + 1 * DM, vec + VEC_QKV, vec + VEC_QKV + 3072, rot);
    conv_matrix<0, false>(p.attn_w_out, 2048, 2048, (h16*)(ws + OFF_WAO), L, nullptr, nullptr, nullptr, nullptr, rot);
    conv_matrix<1, true>(p.ffn_w_gu, 2048, 11264, (h16*)(ws + OFF_WGU0), L, p.ln_g + 0 * DM, p.ln_b + 0 * DM, vec + VEC_GU0, vec + VEC_GU0 + 11264, rot);
    conv_matrix<1, true>(p.ffn_w_gu + (size_t)2048 * 11264, 2048, 11264, (h16*)(ws + OFF_WGU1), L, p.ln_g + 2 * DM, p.ln_b + 2 * DM, vec + VEC_GU1, vec + VEC_GU1 + 11264, rot);
    conv_matrix<0, false>(p.ffn_w_down, 5632, 2048, (h16*)(ws + OFF_WDN0), L, nullptr, nullptr, nullptr, nullptr, rot);
    conv_matrix<0, false>(p.ffn_w_down + (size_t)5632 * 2048, 5632, 2048, (h16*)(ws + OFF_WDN1), L, nullptr, nullptr, nullptr, nullptr, rot);
    for (int tile = blockIdx.x; tile < 256; tile += gridDim.x) {
        const int mat = tile >> 2, sub = tile & 3, ti = sub >> 1, to = sub & 1;
        const int eg = mat >> 4, n = mat & 15;
        conv_tile<false>(p.lru_gate_w + (size_t)mat * 16384 + (size_t)(ti * 64) * 128 + to * 64, 128,
                  (h16*)(ws + OFF_GT) + (size_t)(n * 4 + eg) * 16384 + (size_t)(to * 64) * 128 + ti * 64, 128, L, nullptr, nullptr, nullptr, nullptr);
    }
    h16* xh = (h16*)(ws + OFF_XH);
    const size_t nchunk = (size_t)NT * DM / 8, half = (size_t)8192 * DM / 8;
    const size_t stride = (size_t)gridDim.x * 512;
    for (size_t i = (size_t)blockIdx.x * 512 + lnd_tid(); i < nchunk; i += 4 * stride) {
        f32x4 a[4], b[4];
#pragma unroll
        for (int q = 0; q < 4; ++q) { const size_t k = i + q * stride; const float* sp = (k < half) ? p.x_prompt + k * 8 : p.x_sample + (k - half) * 8; a[q] = ldg4(sp); b[q] = ldg4(sp + 4); }
#pragma unroll
        for (int q = 0; q < 4; ++q) { const size_t k = i + q * stride;
            u32x4 w; w.x = pk2(a[q].x, a[q].y); w.y = pk2(a[q].z, a[q].w); w.z = pk2(b[q].x, b[q].y); w.w = pk2(b[q].z, b[q].w);
            *(GAS u32x4*)(xh + k * 8) = w; }
    }
}

constexpr int XR_LD = 136;
__device__ __forceinline__ float one_minus_exp2la(float la, float a) {
    const float y = 2.0f * la;
    const float poly = -y * (1.0f + y * (0.5f + y * (1.0f / 6.0f + y * (1.0f / 24.0f + y * (1.0f / 120.0f + y * (1.0f / 720.0f))))));
    return (y > -0.25f) ? poly : (1.0f - a * a);
}
__device__ __forceinline__ f32x4 exp2v(f32x4 x) { f32x4 r; r[0] = __builtin_amdgcn_exp2f(x[0]); r[1] = __builtin_amdgcn_exp2f(x[1]); r[2] = __builtin_amdgcn_exp2f(x[2]); r[3] = __builtin_amdgcn_exp2f(x[3]); return r; }
__device__ __forceinline__ f32x4 rcpv(f32x4 x) { f32x4 r; r[0] = __builtin_amdgcn_rcpf(x[0]); r[1] = __builtin_amdgcn_rcpf(x[1]); r[2] = __builtin_amdgcn_rcpf(x[2]); r[3] = __builtin_amdgcn_rcpf(x[3]); return r; }
__device__ __forceinline__ void gate_au(f32x4 ar, f32x4 ai, float gbr, float gbi, float nsp, f32x4 xv, f32x4& a, f32x4& u) {
    const float L2E = 1.4426950408889634f;
    const f32x4 rg = rcpv(exp2v(ar * (-L2E) + (-L2E * gbr)) + 1.0f), ig = rcpv(exp2v(ai * (-L2E) + (-L2E * gbi)) + 1.0f);
    const f32x4 la = rg * nsp; a = exp2v(la * L2E);
    const f32x4 y = la + la;
    const f32x4 poly = -y * (y * (y * (y * (y * (y * (1.0f / 720.0f) + (1.0f / 120.0f)) + (1.0f / 24.0f)) + (1.0f / 6.0f)) + 0.5f) + 1.0f);
    f32x4 polyp = poly, dir = 1.0f - a * a;
    asm volatile("" : "+v"(polyp), "+v"(dir));
    f32x4 om;
#pragma unroll
    for (int j = 0; j < 4; ++j) om[j] = (y[j] > -0.25f) ? polyp[j] : dir[j];
    f32x4 sq; sq[0] = __builtin_amdgcn_sqrtf(om[0]); sq[1] = __builtin_amdgcn_sqrtf(om[1]); sq[2] = __builtin_amdgcn_sqrtf(om[2]); sq[3] = __builtin_amdgcn_sqrtf(om[3]);
    u = sq * ig * xv;
}
__device__ void lru_local_phase(const Params& p, unsigned char* ldsb) {
    unsigned char* ws = lnd(p.ws);
    const GAS h16* xpre = (const GAS h16*)(ws + OFF_R + SZ_ACT);
    GAS h16* HL = (GAS h16*)(ws + OFF_R + 2 * SZ_ACT); GAS h16* PF = (GAS h16*)(ws + OFF_R + 3 * SZ_ACT); GAS h16* PB = (GAS h16*)(ws + OFF_R + 4 * SZ_ACT);
    GAS float* aggA = (GAS float*)(ws + OFF_AGGA); GAS float* aggH = (GAS float*)(ws + OFF_AGGH);
    const GAS h16* Gt = (const GAS h16*)(ws + OFF_GT);
    h16* xr = (h16*)ldsb;
    const int tid = lnd_tid(), w = tid >> 6, lane = tid & 63, fr = lane & 15, fq = lane >> 4;
    const int nblk = blockIdx.x >> 4, tile0 = (blockIdx.x & 15) * 8;
    const int cl = 16 * w + fr, c = 128 * nblk + cl;
    f16x8 Bid;
#pragma unroll
    for (int j = 0; j < 8; ++j) Bid[j] = (8 * fq + j == 16 * (w & 1) + fr) ? (h16)1.0f : (h16)0.0f;
    float gb[4], nsp[2];
#pragma unroll
    for (int eg = 0; eg < 4; ++eg) gb[eg] = ((const GAS float*)p.lru_gate_b)[(eg * 16 + nblk) * 128 + cl];
#pragma unroll
    for (int e = 0; e < 2; ++e) { const float x = -((const GAS float*)p.lru_lambda)[e * 2048 + c]; nsp[e] = -8.0f * (fmaxf(x, 0.f) + log1pf(expf(-fabsf(x)))); }
    const int cg8 = (tid & 15) * 8, tg = tid >> 4;

    f16x8 pre[7];
#define LRU_PRELOAD(tile_) do { const int t0_ = (tile_) * 128; int s0_, s1_; seq_bounds(t0_, s0_, s1_); _Pragma("unroll") for (int i = 0; i < 7; ++i) { \
        const int tr = t0_ + 4 * tg - 2 + i; pre[i] = (f16x8){0, 0, 0, 0, 0, 0, 0, 0}; \
        if (tr >= s0_ && tr < s1_) pre[i] = *(const GAS f16x8*)(xpre + (size_t)tr * DM + 128 * nblk + cg8); } } while (0)
    LRU_PRELOAD(tile0);
    for (int it = 0; it < 8; ++it) {
        const int tile = tile0 + it, t0 = tile * 128;
        {
            float cw[4][8], cb[8];
            { const float* cbp = p.lru_conv_b + 128 * nblk + cg8; const f32x4 b0 = ldg4(cbp), b1 = ldg4(cbp + 4);
#pragma unroll
              for (int j = 0; j < 4; ++j) { cb[j] = b0[j]; cb[4 + j] = b1[j]; }
#pragma unroll
              for (int k = 0; k < 4; ++k) { const float* wp = p.lru_conv_w + k * 2048 + 128 * nblk + cg8; const f32x4 w0 = ldg4(wp), w1 = ldg4(wp + 4);
#pragma unroll
                  for (int j = 0; j < 4; ++j) { cw[k][j] = w0[j]; cw[k][4 + j] = w1[j]; } } }
            float o[4][8];
#pragma unroll
            for (int j = 0; j < 4; ++j)
#pragma unroll
                for (int q = 0; q < 8; ++q) o[j][q] = cb[q];
#pragma unroll
            for (int i = 0; i < 7; ++i) {
                const f16x8 v = pre[i];
#pragma unroll
                for (int j = 0; j < 4; ++j) { const int k = i - j; if (k >= 0 && k < 4) {
#pragma unroll
                        for (int q = 0; q < 8; ++q) o[j][q] += cw[k][q] * (float)v[q]; } }
            }
#pragma unroll
            for (int j = 0; j < 4; ++j) { u32x4 wv; wv.x = pk2(o[j][0], o[j][1]); wv.y = pk2(o[j][2], o[j][3]); wv.z = pk2(o[j][4], o[j][5]); wv.w = pk2(o[j][6], o[j][7]);
                *(u32x4*)(xr + (4 * tg + j) * XR_LD + cg8) = wv; }
        }
        lds_barrier();
        float* hfl = (float*)(ldsb + 128 * XR_LD * 2);
        const size_t tg0 = (size_t)(t0 >> 2);
        const int arow = 32 * (fr >> 2) + (fr & 3);
        f16x8 Bb[2][4];
        {
            float Prun = 1.f, hrun = 0.f;
            f16x8 Bf[2][4];
#pragma unroll
            for (int eg = 0; eg < 2; ++eg)
#pragma unroll
                for (int ks = 0; ks < 4; ++ks) Bf[eg][ks] = *(const GAS f16x8*)(Gt + ((size_t)(nblk * 4 + eg) * 128 + cl) * 128 + 32 * ks + 8 * fq);
#pragma unroll
            for (int m = 0; m < 8; ++m) {
                if (m == 6) {
#pragma unroll
                    for (int eg = 0; eg < 2; ++eg)
#pragma unroll
                        for (int ks = 0; ks < 4; ++ks) Bb[eg][ks] = *(const GAS f16x8*)(Gt + ((size_t)(nblk * 4 + 2 + eg) * 128 + cl) * 128 + 32 * ks + 8 * fq);
                }
                f32x4 ar = {0.f, 0.f, 0.f, 0.f}, ai = {0.f, 0.f, 0.f, 0.f};
#pragma unroll
                for (int ks = 0; ks < 4; ++ks) { const f16x8 Af = *(const f16x8*)(xr + (arow + 4 * m) * XR_LD + 32 * ks + 8 * fq);
                    ar = __builtin_amdgcn_mfma_f32_16x16x32_f16(Af, Bf[0][ks], ar, 0, 0, 0); ai = __builtin_amdgcn_mfma_f32_16x16x32_f16(Af, Bf[1][ks], ai, 0, 0, 0); }
                f32x4 a, u;
                const f32x4 xv = __builtin_amdgcn_mfma_f32_16x16x32_f16(*(const f16x8*)(xr + (arow + 4 * m) * XR_LD + 32 * (w >> 1) + 8 * fq), Bid, (f32x4){0.f, 0.f, 0.f, 0.f}, 0, 0, 0);
                gate_au(ar, ai, gb[0], gb[1], nsp[0], xv, a, u);
                f32x4 hv, pv;
#pragma unroll
                for (int r = 0; r < 4; ++r) { hrun = a[r] * hrun + u[r]; Prun *= a[r]; hv[r] = hrun; pv[r] = Prun; }
                *(f32x4*)(hfl + ((m * 4 + fq) * 128 + cl) * 4) = hv;
                { u32x2 w; w.x = pk2(pv[0], pv[1]); w.y = pk2(pv[2], pv[3]); *(GAS u32x2*)(PF + ((tg0 + 8 * fq + m) * DM + c) * 4) = w; }
            }
            aggA[(size_t)((tile * 4 + fq) * 2 + 0) * 2048 + c] = Prun; aggH[(size_t)((tile * 4 + fq) * 2 + 0) * 2048 + c] = hrun;
        }
        if (it < 7) LRU_PRELOAD(tile + 1);
        {
            float Prun = 1.f, hrun = 0.f;
#pragma unroll
            for (int mm = 0; mm < 8; ++mm) { const int m = 7 - mm;
                f32x4 ar = {0.f, 0.f, 0.f, 0.f}, ai = {0.f, 0.f, 0.f, 0.f};
#pragma unroll
                for (int ks = 0; ks < 4; ++ks) { const f16x8 Af = *(const f16x8*)(xr + (arow + 4 * m) * XR_LD + 32 * ks + 8 * fq);
                    ar = __builtin_amdgcn_mfma_f32_16x16x32_f16(Af, Bb[0][ks], ar, 0, 0, 0); ai = __builtin_amdgcn_mfma_f32_16x16x32_f16(Af, Bb[1][ks], ai, 0, 0, 0); }
                f32x4 a, u;
                const f32x4 xv = __builtin_amdgcn_mfma_f32_16x16x32_f16(*(const f16x8*)(xr + (arow + 4 * m) * XR_LD + 32 * (w >> 1) + 8 * fq), Bid, (f32x4){0.f, 0.f, 0.f, 0.f}, 0, 0, 0);
                gate_au(ar, ai, gb[2], gb[3], nsp[1], xv, a, u);
                f32x4 hv, pv;
#pragma unroll
                for (int rr = 0; rr < 4; ++rr) { const int r = 3 - rr; hrun = a[r] * hrun + u[r]; Prun *= a[r]; hv[r] = hrun; pv[r] = Prun; }
                const f32x4 hfv = *(const f32x4*)(hfl + ((m * 4 + fq) * 128 + cl) * 4); const f32x4 hs = hfv + hv;
                const size_t o = ((tg0 + 8 * fq + m) * DM + c) * 4;
                { u32x2 w; w.x = pk2(pv[0], pv[1]); w.y = pk2(pv[2], pv[3]); *(GAS u32x2*)(PB + o) = w; }
                { u32x2 w; w.x = pk2(hs[0], hs[1]); w.y = pk2(hs[2], hs[3]); *(GAS u32x2*)(HL + o) = w; }
            }
            aggA[(size_t)((tile * 4 + fq) * 2 + 1) * 2048 + c] = Prun; aggH[(size_t)((tile * 4 + fq) * 2 + 1) * 2048 + c] = hrun;
        }
        lds_barrier();
    }
}
__device__ void lru_carry_phase(const Params& p) {
    unsigned char* ws = lnd(p.ws);
    const GAS float* aggA = (const GAS float*)(ws + OFF_AGGA); const GAS float* aggH = (const GAS float*)(ws + OFF_AGGH); GAS float* carry = (GAS float*)(ws + OFF_CARRY);
    const int gt = blockIdx.x * 512 + lnd_tid();
    if (gt >= 5 * 2 * 2048) return;
    const int seq = gt / 4096, rem = gt % 4096, dir = rem / 2048, c = rem % 2048;
    const int run0 = (seq == 0 ? 0 : 64 + 16 * (seq - 1)) * 4, nrun = (seq == 0 ? 64 : 16) * 4;
    float cy = 0.f;
    for (int b = 0; b < nrun; b += 32) {
        float Hh[32], Aa[32];
#pragma unroll
        for (int u = 0; u < 32; ++u) { const int j = dir == 0 ? run0 + b + u : run0 + nrun - 1 - b - u; const size_t i = (size_t)(j * 2 + dir) * 2048 + c; Hh[u] = aggH[i]; Aa[u] = aggA[i]; }
#pragma unroll
        for (int u = 0; u < 32; ++u) { const int j = dir == 0 ? run0 + b + u : run0 + nrun - 1 - b - u; carry[(size_t)(j * 2 + dir) * 2048 + c] = cy; cy = Hh[u] + Aa[u] * cy; }
    }
}
__device__ void lru_fixup_phase(const Params& p) {
    unsigned char* ws = lnd(p.ws);
    const GAS h16* YB = (const GAS h16*)(ws + OFF_R); const GAS h16* HL = (const GAS h16*)(ws + OFF_R + 2 * SZ_ACT); const GAS h16* PF = (const GAS h16*)(ws + OFF_R + 3 * SZ_ACT); const GAS h16* PB = (const GAS h16*)(ws + OFF_R + 4 * SZ_ACT);
    const GAS float* carry = (const GAS float*)(ws + OFF_CARRY); GAS h16* out = (GAS h16*)(ws + OFF_XH);
    for (int i = blockIdx.x * 512 + lnd_tid(); i < (NT / 4) * 256; i += gridDim.x * 512) {
        const int tg = i >> 8, c8 = (i & 255) * 8, tile = tg >> 3; const size_t o4 = ((size_t)tg * DM + c8) * 4;
        f16x8 hl[4], pf[4], pb[4], y[4];
#pragma unroll
        for (int q = 0; q < 4; ++q) { hl[q] = *(const GAS f16x8*)(HL + o4 + 8 * q); pf[q] = *(const GAS f16x8*)(PF + o4 + 8 * q); pb[q] = *(const GAS f16x8*)(PB + o4 + 8 * q); y[q] = *(const GAS f16x8*)(YB + (size_t)(4 * tg + q) * DM + c8); }
        const GAS float* cf = carry + (size_t)(tile * 2) * 2048 + c8; const GAS float* cbk = cf + 2048;
        const f32x4 cf0 = *(const GAS f32x4*)cf, cf1 = *(const GAS f32x4*)(cf + 4), cb0 = *(const GAS f32x4*)cbk, cb1 = *(const GAS f32x4*)(cbk + 4);
#pragma unroll
        for (int r = 0; r < 4; ++r) {
            float v[8];
#pragma unroll
            for (int j = 0; j < 8; ++j) { const float cfj = j < 4 ? cf0[j & 3] : cf1[j & 3], cbj = j < 4 ? cb0[j & 3] : cb1[j & 3]; const int e = (j & 1) * 4 + r;
                v[j] = (float)y[r][j] * ((float)hl[j >> 1][e] + (float)pf[j >> 1][e] * cfj + (float)pb[j >> 1][e] * cbj); }
            u32x4 wv; wv.x = pk2(v[0], v[1]); wv.y = pk2(v[2], v[3]); wv.z = pk2(v[4], v[5]); wv.w = pk2(v[6], v[7]);
            *(GAS u32x4*)(out + (size_t)(4 * tg + r) * DM + c8) = wv;
        }
    }
}

__device__ void ln_final_phase(const h16* z0, const float* g0, const float* b0, float* out0) {
    const GAS h16* z = (const GAS h16*)lnd(z0); const float* g = lnd(g0); const float* b = lnd(b0); float* out = lnd(out0);
    const int tidl = lnd_tid(), lane = tidl & 63, gw = blockIdx.x * 8 + (tidl >> 6), nw = gridDim.x * 8;
    for (int row0 = gw; row0 < NT; row0 += 2 * nw) {
        f16x8 hv[2][4];
#pragma unroll
        for (int r = 0; r < 2; ++r)
#pragma unroll
            for (int i = 0; i < 4; ++i) hv[r][i] = *(const GAS f16x8*)(z + (size_t)(row0 + r * nw) * DM + 8 * (lane + 64 * i));
#pragma unroll
        for (int r = 0; r < 2; ++r) {
            const int row = row0 + r * nw; float s = 0.f;
#pragma unroll
            for (int i = 0; i < 4; ++i)
#pragma unroll
                for (int j = 0; j < 8; ++j) s += (float)hv[r][i][j];
#pragma unroll
            for (int o = 32; o >= 1; o >>= 1) s += __shfl_xor(s, o);
            const float mean = s * (1.0f / DM); float q = 0.f;
#pragma unroll
            for (int i = 0; i < 4; ++i)
#pragma unroll
                for (int j = 0; j < 8; ++j) { const float d = (float)hv[r][i][j] - mean; q += d * d; }
#pragma unroll
            for (int o = 32; o >= 1; o >>= 1) q += __shfl_xor(q, o);
            const float rstd = rsqrtf(q * (1.0f / DM) + LN_EPS);
#pragma unroll
            for (int i = 0; i < 4; ++i) { const int col = 8 * (lane + 64 * i);
                const f32x4 g0v = ldg4(g + col), g1v = ldg4(g + col + 4), b0v = ldg4(b + col), b1v = ldg4(b + col + 4);
                f32x4 y0, y1;
#pragma unroll
                for (int j = 0; j < 4; ++j) { y0[j] = ((float)hv[r][i][j] - mean) * rstd * g0v[j] + b0v[j]; y1[j] = ((float)hv[r][i][4 + j] - mean) * rstd * g1v[j] + b1v[j]; }
                stg4(out + (size_t)row * DM + col, y0); stg4(out + (size_t)row * DM + col + 4, y1); }
        }
    }
}

constexpr int KS_LD = 136, VS_LD = 72, BT_LD = 384;
__device__ void attn_phase(const Params& p, unsigned char* ldsb) {
    unsigned char* ws = lnd(p.ws);
    const GAS h16* Q = (const GAS h16*)(ws + OFF_R); const GAS h16* Kk = (const GAS h16*)(ws + OFF_R + SZ_ACT); const GAS h16* VT = (const GAS h16*)(ws + OFF_R + SZ_ACT + (size_t)NT * 512 * 2);
    GAS h16* O = (GAS h16*)(ws + OFF_XH);
    constexpr int KVB = 64 * KS_LD * 2 + 128 * VS_LD * 2;
    float* Bt = (float*)(ldsb + 2 * KVB);
    const int tid = lnd_tid(), w = tid >> 6, lane = tid & 63, fr = lane & 15, fq = lane >> 4;
    const int kvh = blockIdx.x & 3, g = w >> 1, h = kvh * 4 + g, qhalf = w & 1;
    for (int i = tid; i < 4 * BT_LD; i += 512) { const int gg = i / BT_LD, rel = i % BT_LD - 192, n = rel < 0 ? -rel : rel;
        int bk; if (n < 8) bk = n; else { int lg = (31 - __clz(n * n)) - 6; bk = 8 + lg; if (bk > 15) bk = 15; }
        if (rel > 0) bk += 16;
        Bt[i] = (n <= 128) ? ((const GAS float*)p.rel_bias)[bk * 16 + kvh * 4 + gg] * 1.4426950408889634f : -1.0e30f; }
    lds_barrier();
    const float sk = ((const GAS float*)p.attn_sink)[h] * 1.4426950408889634f;
    const int kkey = tid >> 4, kdc = (tid & 15) * 8;
    const int vd = tid >> 3, vkc = (tid & 7) * 8;
    for (int it = 0; it < 4; ++it) {
        const int item = blockIdx.x + 256 * it, qb = item >> 2, t0 = qb * 64; int s0, s1; seq_bounds(t0, s0, s1);
        int qtok[2]; f16x8 Qf[2][4];
#pragma unroll
        for (int qt = 0; qt < 2; ++qt) { qtok[qt] = t0 + 32 * qhalf + 16 * qt + fr;
#pragma unroll
            for (int ks = 0; ks < 4; ++ks) Qf[qt][ks] = *(const GAS f16x8*)(Q + (size_t)qtok[qt] * DM + h * 128 + 32 * ks + 8 * fq); }
        float mrun[2] = {sk, sk}, lrun[2]; lrun[0] = lrun[1] = (fq == 0) ? 1.f : 0.f;
        f32x4 Oa[8][2];
#pragma unroll
        for (int dt = 0; dt < 8; ++dt) { Oa[dt][0] = (f32x4){0.f, 0.f, 0.f, 0.f}; Oa[dt][1] = (f32x4){0.f, 0.f, 0.f, 0.f}; }
        int kt_lo = 0, kt_hi = 4;
        while (t0 - 128 + 64 * kt_lo < s0) ++kt_lo;
        while (t0 - 128 + 64 * kt_hi + 64 > s1) --kt_hi;
        u32x4 pk0, pk1, pv0, pv1;
        { const int kb = t0 - 128 + 64 * kt_lo;
          pk0 = *(const GAS u32x4*)(Kk + (size_t)(kb + kkey) * 512 + kvh * 128 + kdc); pk1 = *(const GAS u32x4*)(Kk + (size_t)(kb + kkey + 32) * 512 + kvh * 128 + kdc);
          pv0 = *(const GAS u32x4*)(VT + (size_t)(kvh * 128 + vd) * NT + kb + vkc); pv1 = *(const GAS u32x4*)(VT + (size_t)(kvh * 128 + vd + 64) * NT + kb + vkc); }
        lds_barrier();
        { h16* Kw = (h16*)ldsb; h16* Vw = Kw + 64 * KS_LD;
          *(u32x4*)(Kw + kkey * KS_LD + kdc) = pk0; *(u32x4*)(Kw + (kkey + 32) * KS_LD + kdc) = pk1;
          *(u32x4*)(Vw + vd * VS_LD + vkc) = pv0; *(u32x4*)(Vw + (vd + 64) * VS_LD + vkc) = pv1; }
        for (int kt = kt_lo; kt <= kt_hi; ++kt) {
            const int kb = t0 - 128 + 64 * kt, cur = (kt - kt_lo) & 1;
            const h16* Ks = (const h16*)(ldsb + cur * KVB); const h16* Vs = Ks + 64 * KS_LD;
            if (kt < kt_hi) { const int kn = kb + 64;
                pk0 = *(const GAS u32x4*)(Kk + (size_t)(kn + kkey) * 512 + kvh * 128 + kdc); pk1 = *(const GAS u32x4*)(Kk + (size_t)(kn + kkey + 32) * 512 + kvh * 128 + kdc);
                pv0 = *(const GAS u32x4*)(VT + (size_t)(kvh * 128 + vd) * NT + kn + vkc); pv1 = *(const GAS u32x4*)(VT + (size_t)(kvh * 128 + vd + 64) * NT + kn + vkc); }
            lds_barrier();
            f32x4 S[4][2];
#pragma unroll
            for (int kp = 0; kp < 4; ++kp)
#pragma unroll
                for (int qt = 0; qt < 2; ++qt) { const float* bp = Bt + g * BT_LD + (kb + 4 * fq - qtok[qt] + 192) + 16 * kp;
                    S[kp][qt] = (f32x4){bp[0], bp[1], bp[2], bp[3]}; }
#pragma unroll
            for (int ks = 0; ks < 4; ++ks)
#pragma unroll
                for (int kp = 0; kp < 4; ++kp) { const f16x8 Kf = *(const f16x8*)(Ks + (16 * kp + fr) * KS_LD + 32 * ks + 8 * fq);
                    S[kp][0] = __builtin_amdgcn_mfma_f32_16x16x32_f16(Kf, Qf[0][ks], S[kp][0], 0, 0, 0);
                    S[kp][1] = __builtin_amdgcn_mfma_f32_16x16x32_f16(Kf, Qf[1][ks], S[kp][1], 0, 0, 0); }
            f16x8 Pf[2][2];
#pragma unroll
            for (int qt = 0; qt < 2; ++qt) {
                float tmax = -3.0e38f;
#pragma unroll
                for (int kp = 0; kp < 4; ++kp)
#pragma unroll
                    for (int r = 0; r < 4; ++r) tmax = fmaxf(tmax, S[kp][qt][r]);
                if (__builtin_amdgcn_ballot_w64(tmax > mrun[qt] + 8.0f) != 0ull) {
                    tmax = fmaxf(tmax, __shfl_xor(tmax, 16)); tmax = fmaxf(tmax, __shfl_xor(tmax, 32));
                    const float mnew = fmaxf(mrun[qt], tmax), alpha = __builtin_amdgcn_exp2f(mrun[qt] - mnew); mrun[qt] = mnew; lrun[qt] *= alpha;
#pragma unroll
                    for (int dt = 0; dt < 8; ++dt) Oa[dt][qt] *= alpha;
                }
                const float mref = mrun[qt];
                float ls = 0.f;
#pragma unroll
                for (int kp = 0; kp < 4; ++kp)
#pragma unroll
                    for (int r = 0; r < 4; ++r) { const float pe = __builtin_amdgcn_exp2f(S[kp][qt][r] - mref); S[kp][qt][r] = pe; ls += pe; }
                lrun[qt] += ls;
#pragma unroll
                for (int i = 0; i < 2; ++i) { f16x8 pf;
#pragma unroll
                    for (int j = 0; j < 4; ++j) { pf[j] = (h16)S[2 * i][qt][j]; pf[4 + j] = (h16)S[2 * i + 1][qt][j]; }
                    Pf[i][qt] = pf; }
            }
#pragma unroll
            for (int dt = 0; dt < 8; ++dt)
#pragma unroll
                for (int i = 0; i < 2; ++i) {
                    const f16x4 va = *(const f16x4*)(Vs + (16 * dt + fr) * VS_LD + 32 * i + 4 * fq), vb = *(const f16x4*)(Vs + (16 * dt + fr) * VS_LD + 32 * i + 16 + 4 * fq);
                    const f16x8 Vf = __builtin_shufflevector(va, vb, 0, 1, 2, 3, 4, 5, 6, 7);
                    Oa[dt][0] = __builtin_amdgcn_mfma_f32_16x16x32_f16(Vf, Pf[i][0], Oa[dt][0], 0, 0, 0);
                    Oa[dt][1] = __builtin_amdgcn_mfma_f32_16x16x32_f16(Vf, Pf[i][1], Oa[dt][1], 0, 0, 0); }
            if (kt < kt_hi) { h16* Kw = (h16*)(ldsb + (cur ^ 1) * KVB); h16* Vw = Kw + 64 * KS_LD;
                *(u32x4*)(Kw + kkey * KS_LD + kdc) = pk0; *(u32x4*)(Kw + (kkey + 32) * KS_LD + kdc) = pk1;
                *(u32x4*)(Vw + vd * VS_LD + vkc) = pv0; *(u32x4*)(Vw + (vd + 64) * VS_LD + vkc) = pv1; }
        }
#pragma unroll
        for (int qt = 0; qt < 2; ++qt) { float l = lrun[qt]; l += __shfl_xor(l, 16); l += __shfl_xor(l, 32); const float inv = 1.0f / l;
#pragma unroll
            for (int dt = 0; dt < 8; ++dt) { const f32x4 o = Oa[dt][qt] * inv; u32x2 wv; wv.x = pk2(o[0], o[1]); wv.y = pk2(o[2], o[3]);
                *(GAS u32x2*)(O + (size_t)qtok[qt] * DM + h * 128 + 16 * dt + 4 * fq) = wv; } }
    }
}

#define XB_TMO      128
#define XB_XCNT(j)  (256  + 64 * (j))
#define XB_XSUB(j)  (1280 + 64 * (j))
#define XB_XGEN(j)  (2304 + 64 * (j))
#define XB_TOP      3328
#define XB_TOPGEN   3392
#define XCD_BAR_WORDS 3456
#define XB_SPIN_CAP (1u << 20)
__device__ __forceinline__ unsigned xb_ld(unsigned* p)              { return __hip_atomic_load(p, __ATOMIC_RELAXED, __HIP_MEMORY_SCOPE_AGENT); }
__device__ __forceinline__ unsigned xb_add(unsigned* p, unsigned v) { return __hip_atomic_fetch_add(p, v, __ATOMIC_RELAXED, __HIP_MEMORY_SCOPE_AGENT); }
__device__ __forceinline__ unsigned xb_xcc_id() { return (unsigned)__builtin_amdgcn_s_getreg((3 << 11) | 20) & 0xFu; }
#define XB_SPIN(cond, bar) do { unsigned _sp = 0; while (cond) { __builtin_amdgcn_s_sleep(1); \
    if ((++_sp & 255u) == 0u) { if (xb_ld(&(bar)[XB_TMO])) break; if (_sp > XB_SPIN_CAP) { atomicAdd(&(bar)[XB_TMO], 1u); break; } } } } while (0)
struct XcdBarrier { unsigned* bar; unsigned x; volatile LAS unsigned* st; };
__device__ __forceinline__ XcdBarrier xcd_barrier_post(unsigned* bar, volatile LAS unsigned* st) {
    XcdBarrier b; b.bar = bar; b.x = xb_xcc_id(); b.st = st;
    if (threadIdx.x == 0) (void)xb_add(&bar[XB_XCNT(b.x)], 1u);
    return b;
}
__device__ __forceinline__ void xcd_barrier_complete(unsigned* bar, unsigned x, unsigned& nloc, unsigned& nx) {
    const unsigned G = gridDim.x * gridDim.y * gridDim.z;
    unsigned sum, cnt, mine, sp = 0u;
    for (;;) {
        sum = 0u; cnt = 0u; mine = 0u;
#pragma unroll
        for (unsigned j = 0; j < 16; ++j) { const unsigned c = xb_ld(&bar[XB_XCNT(j)]); sum += c; cnt += (c > 0u) ? 1u : 0u; mine = (j == x) ? c : mine; }
        if (sum == G) break;
        __builtin_amdgcn_s_sleep(1);
        if ((++sp & 255u) == 0u) { if (xb_ld(&bar[XB_TMO])) break; if (sp > XB_SPIN_CAP) { atomicAdd(&bar[XB_TMO], 1u); break; } }
    }
    nloc = mine > 0u ? mine : 1u; nx = cnt > 0u ? cnt : 1u;
}
__device__ __forceinline__ void xcd_barrier_census(const XcdBarrier& b) {
    if (threadIdx.x == 0) { unsigned nloc, nx; xcd_barrier_complete(b.bar, b.x, nloc, nx); b.st[0] = nloc; b.st[1] = nx; }
    __syncthreads();
}
__device__ __forceinline__ void xcd_barrier(const XcdBarrier& b) {
    asm volatile("s_waitcnt vmcnt(0)" ::: "memory");
    __syncthreads();
    if (threadIdx.x == 0) {
        unsigned* bar = b.bar;
        __builtin_amdgcn_s_waitcnt(0);
        const unsigned nloc = b.st[0], nx = b.st[1];
        const unsigned old = xb_add(&bar[XB_XSUB(b.x)], 1u);
        const unsigned gen = old / nloc;
        if (old + 1u == (gen + 1u) * nloc) {
            __builtin_amdgcn_fence(__ATOMIC_RELEASE, "agent");
            asm volatile("s_waitcnt vmcnt(0)" ::: "memory");
            const unsigned og = xb_add(&bar[XB_TOP], 1u);
            const unsigned tg = og / nx;
            if (og + 1u == (tg + 1u) * nx) xb_add(&bar[XB_TOPGEN], 1u);
            else XB_SPIN(xb_ld(&bar[XB_TOPGEN]) == tg, bar);
            __builtin_amdgcn_fence(__ATOMIC_ACQUIRE, "agent");
            xb_add(&bar[XB_XGEN(b.x)], 1u);
            asm volatile("s_waitcnt vmcnt(0)" ::: "memory");
        } else {
            XB_SPIN(xb_ld(&bar[XB_XGEN(b.x)]) == gen, bar);
            __builtin_amdgcn_fence(__ATOMIC_ACQUIRE, "agent");
            asm volatile("s_waitcnt vmcnt(0)" ::: "memory");
        }
    }
    __syncthreads();
}

__global__ void __launch_bounds__(512, 2) mega_fwd(Params p) {
    extern __shared__ __attribute__((aligned(16))) unsigned char lds[];
    cg::grid_group grid = cg::this_grid();
    unsigned char* ws = lnd(p.ws);
    LAS unsigned char* ldsl = (LAS unsigned char*)lds;
    const int G = gridDim.x, bid = blockIdx.x;
    volatile LAS unsigned* xst = (volatile LAS unsigned*)(ldsl + LDS_STAGE);
    if (threadIdx.x < 4) xst[threadIdx.x] = 0u;
    __syncthreads();
    const XcdBarrier xbar = xcd_barrier_post((unsigned*)(ws + OFF_BAR), xst);

#ifndef NO_P0
    phase0(p, (unsigned*)lds);
#endif
    grid.sync();
    xcd_barrier_census(xbar);
#define GSYNC() xcd_barrier(xbar)

#define FRESH() unsigned char* ws = lnd(p.ws); float* out = lnd(p.out); float* stats = (float*)(ws + OFF_STATS); const float* vec = (const float*)(ws + OFF_VEC); \
    h16* XH = (h16*)(ws + OFF_XH); h16* ZH = (h16*)(ws + OFF_R + 4 * SZ_ACT); (void)out; (void)stats; (void)vec; (void)XH; (void)ZH
    for (int l = 0; l < 2; ++l) {
        if (l == 0) {
            { FRESH(); pg8::Gemm g{XH, (const h16*)(ws + OFF_WIN), NT, 4096, DM}; pg8::StaticOrder S; S.init(NT, 4096, G, bid);
              pg8::EpiProj E{(h16*)(ws + OFF_R), (h16*)(ws + OFF_R + SZ_ACT)};
#ifndef NO_PROJ
              pg8::gemm_phase(ldsl, g, S, E);
#endif
            }
            GSYNC();
#ifndef NO_LRU
            lru_local_phase(p, lds);
#endif
            GSYNC();
            lru_carry_phase(p);
            GSYNC();
            lru_fixup_phase(p);
            GSYNC();
        } else {
            { FRESH(); pg8::Gemm g{XH, (const h16*)(ws + OFF_WQKV), NT, NQKV, DM}; pg8::StaticOrder S; S.init(NT, NQKV, G, bid);
              pg8::EpiQKV E{(h16*)(ws + OFF_R), (h16*)(ws + OFF_R + SZ_ACT), (h16*)(ws + OFF_R + SZ_ACT + (size_t)NT * 512 * 2), stats + (size_t)1 * NT * 2, vec + VEC_QKV, vec + VEC_QKV + 3072, (LAS float*)(ldsl + LDS_VEC)};
#ifndef NO_QKV
              pg8::gemm_phase(ldsl, g, S, E);
#endif
            }
            GSYNC();
#ifndef NO_ATT
            attn_phase(p, lds);
#endif
            GSYNC();
        }
        {
            FRESH(); const float* lg = lnd(p.ln_g); const float* lb = lnd(p.ln_b);
            pg8::Gemm g{XH, (const h16*)(ws + (l == 0 ? OFF_WOUT0 : OFF_WAO)), NT, DM, DM}; pg8::StaticOrder S; S.init(NT, DM, G, bid);
            pg8::EpiRes E{l == 0 ? p.x_prompt : out, l == 0 ? p.x_sample : out + (size_t)8192 * DM, out,
                          l == 0 ? nullptr : stats + (size_t)1 * NT * 2, lg + 1 * DM, lb + 1 * DM,
                          lg + (l * 2) * DM, ZH, stats + (size_t)(l * 2) * NT * 2, (LAS float*)(ldsl + LDS_VEC), nullptr};
#ifndef NO_RES1
            pg8::gemm_phase(ldsl, g, S, E);
#endif
        }
        GSYNC();
        { FRESH(); pg8::Gemm g{ZH, (const h16*)(ws + (l == 0 ? OFF_WGU0 : OFF_WGU1)), NT, 2 * DFF, DM}; pg8::StaticOrder S; S.init(NT, 2 * DFF, G, bid);
          pg8::EpiGU E{(h16*)(ws + OFF_R), stats + (size_t)(l * 2) * NT * 2, vec + (l == 0 ? VEC_GU0 : VEC_GU1), vec + (l == 0 ? VEC_GU0 : VEC_GU1) + 11264, (LAS float*)(ldsl + LDS_VEC)};
#ifndef NO_GU
          pg8::gemm_phase(ldsl, g, S, E);
#endif
        }
        GSYNC();
        {
            FRESH(); const float* lg = lnd(p.ln_g); const float* lb = lnd(p.ln_b);
            pg8::Gemm g{(const h16*)(ws + OFF_R), (const h16*)(ws + (l == 0 ? OFF_WDN0 : OFF_WDN1)), NT, DM, DFF}; pg8::StaticOrder S; S.init(NT, DM, G, bid);
            pg8::EpiRes E{out, out + (size_t)8192 * DM, out, stats + (size_t)(l * 2) * NT * 2, lg + (l * 2) * DM, lb + (l * 2) * DM,
                          lg + (l * 2 + 1) * DM, l == 0 ? XH : nullptr, stats + (size_t)(l * 2 + 1) * NT * 2, (LAS float*)(ldsl + LDS_VEC), l == 0 ? nullptr : XH};
#ifndef NO_RES2
            pg8::gemm_phase(ldsl, g, S, E);
#endif
        }
        GSYNC();
    }
    ln_final_phase((const h16*)(lnd(p.ws) + OFF_XH), p.ln_g + 3 * DM, p.ln_b + 3 * DM, p.out);
}

extern "C" void kernel_launch(void* const* d_in, const int* in_sizes, int n_in, void* d_out, int out_size, void* d_ws, size_t ws_size, hipStream_t stream) {
    static int grid_blocks = 0;
    if (grid_blocks == 0) {
        if (n_in != 17 || out_size != NT * DM || ws_size < WS_END) { fprintf(stderr, "kernel_launch: unexpected shapes (n_in %d out %d ws %zu need %zu)\n", n_in, out_size, ws_size, (size_t)WS_END); grid_blocks = -1; return; }
        if (hipFuncSetAttribute((const void*)mega_fwd, hipFuncAttributeMaxDynamicSharedMemorySize, LDS_BYTES) != hipSuccess) { fprintf(stderr, "kernel_launch: hipFuncSetAttribute failed\n"); grid_blocks = -1; return; }
        int dev = 0, cus = 0, per_cu = 0;
        hipGetDevice(&dev); hipDeviceGetAttribute(&cus, hipDeviceAttributeMultiprocessorCount, dev);
        hipOccupancyMaxActiveBlocksPerMultiprocessor(&per_cu, (const void*)mega_fwd, 512, LDS_BYTES);
        if (per_cu < 1) { fprintf(stderr, "kernel_launch: occupancy query says %d blocks/CU\n", per_cu); }
        (void)hipGetLastError();
        grid_blocks = 256;
        if (cus < 256) { fprintf(stderr, "kernel_launch: %d CUs < 256\n", cus); grid_blocks = -1; return; }
    }
    if (grid_blocks < 0) return;
    Params p{};
    const float** pp = (const float**)&p;
    for (int i = 0; i < 17; ++i) pp[i] = (const float*)d_in[i];
    p.out = (float*)d_out; p.ws = (unsigned char*)d_ws;
    if (hipMemsetAsync((unsigned char*)d_ws + OFF_BAR, 0, ZERO_BYTES, stream) != hipSuccess) { fprintf(stderr, "kernel_launch: memset of barrier words failed\n"); return; }
    void* args[] = {&p};
    hipError_t e = hipLaunchCooperativeKernel((const void*)mega_fwd, dim3(grid_blocks), dim3(512), args, LDS_BYTES, stream);
    if (e != hipSuccess) fprintf(stderr, "kernel_launch: cooperative launch failed: %s\n", hipGetErrorString(e));
}
```
